# Optimizing an MI355X kernel written in HIP

```python
import math
import jax, jax.numpy as jnp
from jax import lax
import numpy as np

D_MODEL = 1024
BATCH = 8
SEQ = 8192
DEPTH = 2

CHUNK = 64
N_MIXERS = 2
EPS = 1e-6

RET_HEADS = 4
RET_QK_DIM = D_MODEL // RET_HEADS
RET_V_DIM = 2 * D_MODEL // RET_HEADS
RET_QK_WIDTH = RET_HEADS * RET_QK_DIM
RET_WIDTH = RET_HEADS * RET_V_DIM
ROPE_BASE = 10000.0

ATT_HEADS = 16
ATT_HEAD_DIM = 2 * D_MODEL // ATT_HEADS
ATT_WIDTH = ATT_HEADS * ATT_HEAD_DIM
LEFT_CHUNKS = 8
BAND = (LEFT_CHUNKS + 1) * CHUNK
MAX_REL = 2 * CHUNK

N_RET_LAYERS = (DEPTH + 1) // 2
N_ATT_LAYERS = DEPTH // 2

kernel_name = "hybrid_retention_chunked_attention_adaln"


def rms_norm_f32(t, gain):
    t32 = t.astype(jnp.float32)
    return t32 * lax.rsqrt(jnp.mean(t32 * t32, axis=-1, keepdims=True) + EPS) * gain.astype(jnp.float32)


def apply_rope(t, cos, sin):
    t1, t2 = jnp.split(t, 2, axis=-1)
    return jnp.concatenate([t1 * cos - t2 * sin, t1 * sin + t2 * cos], axis=-1)


def retention_mixer(h, positions, w_in, gn_g, w_out):
    B, S, _ = h.shape
    nc = S // CHUNK
    proj = h @ w_in
    q, k, v, g = jnp.split(proj, [RET_QK_WIDTH, 2 * RET_QK_WIDTH, 2 * RET_QK_WIDTH + RET_WIDTH], axis=-1)
    q = q.reshape(B, S, RET_HEADS, RET_QK_DIM).astype(jnp.float32)
    k = k.reshape(B, S, RET_HEADS, RET_QK_DIM).astype(jnp.float32)
    v = v.reshape(B, S, RET_HEADS, RET_V_DIM).astype(jnp.float32)

    inv_freq = 1.0 / (ROPE_BASE ** (jnp.arange(0, RET_QK_DIM, 2, dtype=jnp.float32) / RET_QK_DIM))
    ang = positions.astype(jnp.float32)[..., None] * inv_freq
    cos, sin = jnp.cos(ang)[:, :, None, :], jnp.sin(ang)[:, :, None, :]
    q = apply_rope(q, cos, sin)
    k = apply_rope(k, cos, sin) * (RET_QK_DIM ** -0.5)

    def to_chunks(t):
        return t.reshape(B, nc, CHUNK, RET_HEADS, t.shape[-1]).transpose(0, 3, 1, 2, 4)

    qc, kc, vc = to_chunks(q), to_chunks(k), to_chunks(v)

    log_gamma = jnp.log(1.0 - 2.0 ** (-5.0 - jnp.arange(RET_HEADS, dtype=jnp.float32)))
    idx = jnp.arange(CHUNK, dtype=jnp.float32)
    intra_decay = jnp.exp(log_gamma[:, None, None] * jnp.abs(idx[:, None] - idx[None, :]))
    q_decay = jnp.exp(log_gamma[:, None] * (idx + 1.0))
    k_decay = jnp.exp(log_gamma[:, None] * (CHUNK - 1.0 - idx))
    chunk_decay = jnp.exp(log_gamma * CHUNK)

    scores = jnp.einsum('bhncd,bhnkd->bhnck', qc, kc) * intra_decay[:, None]
    o_intra = jnp.einsum('bhnck,bhnke->bhnce', scores, vc)

    def step(state, xs):
        q_j, k_j, v_j = xs
        o_j = jnp.einsum('bhcd,bhde->bhce', q_j * q_decay[:, :, None], state)
        state = chunk_decay[:, None, None] * state + jnp.einsum(
            'bhcd,bhce->bhde', k_j * k_decay[:, :, None], v_j)
        return state, o_j

    xs = (qc.transpose(2, 0, 1, 3, 4), kc.transpose(2, 0, 1, 3, 4), vc.transpose(2, 0, 1, 3, 4))
    state0 = jnp.zeros((B, RET_HEADS, RET_QK_DIM, RET_V_DIM), jnp.float32)
    _, o_inter = lax.scan(step, state0, xs)

    o = o_intra + o_inter.transpose(1, 2, 0, 3, 4)
    o = o.transpose(0, 2, 3, 1, 4).reshape(B, S, RET_HEADS, RET_V_DIM)
    o = rms_norm_f32(o, gn_g.reshape(RET_HEADS, RET_V_DIM))
    o = o.reshape(B, S, RET_WIDTH) * jax.nn.silu(g.astype(jnp.float32))
    return o.astype(h.dtype) @ w_out


def chunked_attention_mixer(h, w_in, q_g, k_g, rel_table, w_out):
    B, S, _ = h.shape
    nc = S // CHUNK
    proj = h @ w_in
    q, k, v, g = jnp.split(proj, 4, axis=-1)
    q = rms_norm_f32(q.reshape(B, S, ATT_HEADS, ATT_HEAD_DIM), q_g)
    k = rms_norm_f32(k.reshape(B, S, ATT_HEADS, ATT_HEAD_DIM), k_g)
    v = v.reshape(B, S, ATT_HEADS, ATT_HEAD_DIM).astype(jnp.float32)

    pad = LEFT_CHUNKS * CHUNK
    k_pad = jnp.pad(k, ((0, 0), (pad, 0), (0, 0), (0, 0)))
    v_pad = jnp.pad(v, ((0, 0), (pad, 0), (0, 0), (0, 0)))

    qi = jnp.arange(CHUNK)
    kb = jnp.arange(BAND)
    rel = qi[:, None] + pad - kb[None, :]
    bias = rel_table.astype(jnp.float32)[:, jnp.clip(rel, -MAX_REL, MAX_REL) + MAX_REL]
    scale = ATT_HEAD_DIM ** -0.5

    q_chunks = q.reshape(B, nc, CHUNK, ATT_HEADS, ATT_HEAD_DIM).transpose(1, 0, 2, 3, 4)

    def one_chunk(args):
        j, q_j = args
        k_j = lax.dynamic_slice_in_dim(k_pad, j * CHUNK, BAND, axis=1)
        v_j = lax.dynamic_slice_in_dim(v_pad, j * CHUNK, BAND, axis=1)
        s = jnp.einsum('bqhd,bkhd->bhqk', q_j, k_j) * scale + bias
        valid = kb >= (LEFT_CHUNKS - j) * CHUNK
        s = jnp.where(valid, s, jnp.float32(-1e30))
        p = jax.nn.softmax(s, axis=-1)
        return jnp.einsum('bhqk,bkhd->bqhd', p, v_j)

    o = lax.map(one_chunk, (jnp.arange(nc), q_chunks))
    o = o.transpose(1, 0, 2, 3, 4).reshape(B, S, ATT_WIDTH)
    o = o * jax.nn.silu(g.astype(jnp.float32))
    return o.astype(h.dtype) @ w_out


def setup_inputs(seed: int = 0) -> dict:
    key = jax.random.key(seed)
    ks = jax.random.split(key, 16)
    D = D_MODEL
    x = jax.random.normal(ks[0], (BATCH, SEQ, D), jnp.float32)
    c = jax.random.normal(ks[1], (BATCH, D), jnp.float32)
    offsets = jax.random.randint(ks[2], (BATCH, 1), 0, 4096, dtype=jnp.int32)
    positions = offsets + jnp.arange(SEQ, dtype=jnp.int32)[None, :]
    norm_g = 1.0 + 0.1 * jax.random.normal(ks[3], (DEPTH, D), jnp.float32)
    ada_w = jax.random.normal(ks[4], (DEPTH, D, 3 * D), jnp.float32) * D ** -0.5
    ada_b = 0.02 * jax.random.normal(ks[5], (DEPTH, 3 * D), jnp.float32)
    ret_w_in = jax.random.normal(ks[6], (N_RET_LAYERS, D, 2 * RET_QK_WIDTH + 2 * RET_WIDTH), jnp.float32) * D ** -0.5
    ret_gn_g = 1.0 + 0.1 * jax.random.normal(ks[7], (N_RET_LAYERS, RET_WIDTH), jnp.float32)
    ret_w_out = jax.random.normal(ks[8], (N_RET_LAYERS, RET_WIDTH, D), jnp.float32) * RET_WIDTH ** -0.5
    att_w_in = jax.random.normal(ks[9], (N_ATT_LAYERS, D, 4 * ATT_WIDTH), jnp.float32) * D ** -0.5
    att_q_g = 1.0 + 0.1 * jax.random.normal(ks[10], (N_ATT_LAYERS, ATT_HEAD_DIM), jnp.float32)
    att_k_g = 1.0 + 0.1 * jax.random.normal(ks[11], (N_ATT_LAYERS, ATT_HEAD_DIM), jnp.float32)
    att_rel_bias = 0.5 * jax.random.normal(ks[12], (N_ATT_LAYERS, ATT_HEADS, 2 * MAX_REL + 1), jnp.float32)
    att_w_out = jax.random.normal(ks[13], (N_ATT_LAYERS, ATT_WIDTH, D), jnp.float32) * ATT_WIDTH ** -0.5
    return {"x": x, "c": c, "positions": positions, "norm_g": norm_g, "ada_w": ada_w,
            "ada_b": ada_b, "ret_w_in": ret_w_in, "ret_gn_g": ret_gn_g, "ret_w_out": ret_w_out,
            "att_w_in": att_w_in, "att_q_g": att_q_g, "att_k_g": att_k_g,
            "att_rel_bias": att_rel_bias, "att_w_out": att_w_out}


def reference(x, c, positions, norm_g, ada_w, ada_b, ret_w_in, ret_gn_g, ret_w_out,
              att_w_in, att_q_g, att_k_g, att_rel_bias, att_w_out):
    cond = jax.nn.silu(c.astype(jnp.float32))
    for i in range(DEPTH):
        mod = cond @ ada_w[i].astype(jnp.float32) + ada_b[i].astype(jnp.float32)
        shift, scale, gate = jnp.split(mod[:, None, :], 3, axis=-1)
        h = (rms_norm_f32(x, norm_g[i]) * (1.0 + scale) + shift).astype(x.dtype)
        j = i // N_MIXERS
        if i % N_MIXERS == 0:
            out = retention_mixer(h, positions, ret_w_in[j], ret_gn_g[j], ret_w_out[j])
        else:
            out = chunked_attention_mixer(h, att_w_in[j], att_q_g[j], att_k_g[j],
                                          att_rel_bias[j], att_w_out[j])
        x = x + (gate * out.astype(jnp.float32)).astype(x.dtype)
    return x
```

```cpp
#include <hip/hip_runtime.h>
#include <hip/hip_cooperative_groups.h>
#include <cstdio>
#include <cstdint>
namespace cg = cooperative_groups;

#ifndef MK_N_LAUNCHES
#define MK_N_LAUNCHES 1
#endif

namespace pg8 {
#define PG8_LAS __attribute__((address_space(3)))
typedef unsigned short bf16_t;
typedef short bf16x8 __attribute__((ext_vector_type(8)));
typedef float f32x4 __attribute__((ext_vector_type(4)));
typedef unsigned u32x4 __attribute__((ext_vector_type(4)));
constexpr int BM = 256, BK = 64, HALF = 128, HTB = HALF * BK * 2  , STAGE_BYTES = 8 * HTB, NXCD = 8, WGM = 8;

__host__ __device__ __forceinline__ int lds_byte(int r, int c) { const int st = (r >> 4) * 2 + (c >> 5), rr = r & 15, cc = c & 31, ob = rr * 64 + cc * 2; return st * 1024 + (ob ^ (((ob >> 9) & 1) << 5)); }
__host__ __device__ __forceinline__ void stage_rc(int b, int& R, int& C) { const int st = b / 1024, sb = b % 1024, swz = sb ^ (((sb >> 9) & 1) << 5); R = (st >> 1) * 16 + swz / 64; C = (st & 1) * 32 + (swz % 64) / 2; }
__host__ __device__ __forceinline__ int perm32(int rho) { const int n = rho >> 4, i = rho & 15; return 8 * (i >> 2) + 4 * n + (i & 3); }

struct Unit { int pm, pn; };
struct Gemm { const bf16_t* A; const bf16_t* Bt; int M, N, K; };

struct StaticOrder {
    int nM, nN, nwg, G, c;
    __host__ __device__ void init(int M, int N, int G_, int c_) { nM = M / BM; nN = N / BM; nwg = nM * nN; G = G_; c = c_; }
    __host__ __device__ bool next(int i, Unit& u) const {
        const long L = (long)i * G + c; if (L >= nwg) return false;
        int wgid = (int)L; { const int q = nwg / NXCD, r = nwg % NXCD, xcd = wgid % NXCD, off = wgid / NXCD; wgid = (xcd < r ? xcd * (q + 1) : r * (q + 1) + (xcd - r) * q) + off; }
        const int nig = WGM * nN, gid = wgid / nig, fm = gid * WGM, gsz = (nM - fm) < WGM ? (nM - fm) : WGM;
        u.pm = fm + ((wgid % nig) % gsz); u.pn = (wgid % nig) / gsz; return true;
    }
    __device__ __forceinline__ void a_ready(const Unit&) const {}
    __device__ __forceinline__ void done(const Unit&) const {}
};

__device__ __forceinline__ unsigned cvt_pk_bf16(float lo, float hi) { unsigned r; asm volatile("v_cvt_pk_bf16_f32 %0, %1, %2" : "=v"(r) : "v"(lo), "v"(hi)); return r; }
template <class Epi, class Sched, bool ALIGN_EPI = false, bool SP2 = false>
__device__ __forceinline__ void gemm_phase(PG8_LAS unsigned char* lds, const Gemm g, const Sched& S, const Epi& E) {
    const int tid = threadIdx.x, wid = __builtin_amdgcn_readfirstlane(tid >> 6), lane = tid & 63, wr = wid >> 2, wc = wid & 3, fr = lane & 15, fq = lane >> 4;
    const int K = g.K, nt = K / BK;
    unsigned voffA[2], voffB[2];
#pragma unroll
    for (int i = 0; i < 2; ++i) { int R, C; stage_rc(tid * 16 + i * 8192, R, C); const int Rb = Epi::PERM ? ((R & ~31) + perm32(R & 31)) : R;
        voffA[i] = (unsigned)(R * K + C) * 2u; voffB[i] = (unsigned)(Rb * K + C) * 2u; }
    const size_t kstep = (size_t)(BK * 2);
    const size_t hstep = (size_t)HALF * K * 2;
    const size_t tstep = 2 * hstep;
    const unsigned ldsw = (unsigned)wid * 1024u;
    const int aoff = lds_byte(wr * 64 + fr, fq * 8), boff = lds_byte(wc * 32 + fr, fq * 8);
#define PG8_SA(b, h) (((b) * 2 + (h)) * HTB)
#define PG8_SB(b, h) ((4 + (b) * 2 + (h)) * HTB)
#define PG8_STAGE(bufoff, gbase, voff) do { _Pragma("unroll") for (int _i = 0; _i < 2; ++_i) \
        __builtin_amdgcn_global_load_lds((const unsigned*)((const char*)(gbase) + (voff)[_i]), (PG8_LAS unsigned*)(lds + (bufoff) + ldsw + _i * 8192), 16, 0, 0); } while (0)
#define PG8_LDA(dst, b, h) do { _Pragma("unroll") for (int m = 0; m < 4; ++m) _Pragma("unroll") for (int k = 0; k < 2; ++k) dst[m][k] = *(const PG8_LAS bf16x8*)(lds + PG8_SA(b, h) + aoff + m * 2048 + k * 1024); } while (0)
#define PG8_LDB(dst, b, h) do { _Pragma("unroll") for (int n = 0; n < 2; ++n) _Pragma("unroll") for (int k = 0; k < 2; ++k) dst[n][k] = *(const PG8_LAS bf16x8*)(lds + PG8_SB(b, h) + boff + n * 2048 + k * 1024); } while (0)
#define PG8_MMA(ai, bj, At, Bt) do { __builtin_amdgcn_s_setprio(1); _Pragma("unroll") for (int m = 0; m < 4; ++m) _Pragma("unroll") for (int n = 0; n < 2; ++n) _Pragma("unroll") for (int k = 0; k < 2; ++k) \
        acc[ai][bj][m][n] = __builtin_amdgcn_mfma_f32_16x16x32_bf16(Bt[n][k], At[m][k], acc[ai][bj][m][n], 0, 0, 0); __builtin_amdgcn_s_setprio(0); } while (0)
#define PG8_WAIT_V(n) asm volatile("s_waitcnt vmcnt(" #n ")" ::: "memory")
#define PG8_WAIT_L(n) asm volatile("s_waitcnt lgkmcnt(" #n ")" ::: "memory")
#define PG8_BAR __builtin_amdgcn_s_barrier()
#define PG8_SCHED __builtin_amdgcn_sched_barrier(0)
    Unit cur, nxt; int ui = 0;
    if (!S.next(0, cur)) return;
    f32x4 acc[2][2][4][2];
#pragma unroll
    for (int a = 0; a < 2; ++a)
#pragma unroll
        for (int b = 0; b < 2; ++b)
#pragma unroll
            for (int m = 0; m < 4; ++m)
#pragma unroll
                for (int n = 0; n < 2; ++n) acc[a][b][m][n] = (f32x4){0.f, 0.f, 0.f, 0.f};
    bf16x8 At[4][2], B0[2][2], B1[2][2];
    const char* cA = (const char*)g.A + (size_t)cur.pm * tstep; const char* cB = (const char*)g.Bt + (size_t)cur.pn * tstep;
    S.a_ready(cur);
    if constexpr (SP2) {
        PG8_STAGE(PG8_SB(0, 0), cB, voffB); PG8_STAGE(PG8_SB(0, 1), cB + hstep, voffB); PG8_STAGE(PG8_SA(0, 0), cA, voffA); PG8_STAGE(PG8_SA(0, 1), cA + hstep, voffA);
        if (wr == 1) PG8_BAR;
        PG8_WAIT_V(2); PG8_BAR;
        PG8_STAGE(PG8_SB(1, 0), cB + kstep, voffB); PG8_STAGE(PG8_SA(1, 0), cA + kstep, voffA); PG8_STAGE(PG8_SB(1, 1), cB + hstep + kstep, voffB);
        PG8_WAIT_V(6); PG8_BAR;
    } else {
        PG8_STAGE(PG8_SB(0, 0), cB, voffB); PG8_STAGE(PG8_SA(0, 0), cA, voffA); PG8_STAGE(PG8_SB(0, 1), cB + hstep, voffB); PG8_STAGE(PG8_SA(0, 1), cA + hstep, voffA);
        if (wr == 1) PG8_BAR;
        PG8_WAIT_V(4); PG8_BAR;
        PG8_STAGE(PG8_SB(1, 0), cB + kstep, voffB); PG8_STAGE(PG8_SA(1, 0), cA + kstep, voffA); PG8_STAGE(PG8_SB(1, 1), cB + hstep + kstep, voffB);
        PG8_WAIT_V(6); PG8_BAR;
    }
    for (;;) {
        const bool has_next = S.next(ui + 1, nxt);
        const char* nA = has_next ? (const char*)g.A + (size_t)nxt.pm * tstep : cA; const char* nB = has_next ? (const char*)g.Bt + (size_t)nxt.pn * tstep : cB;
        for (int t = 0; t < nt; t += 2) {
            const bool last = (t == nt - 2);
            const char* a1 = cA + (size_t)(t + 1) * kstep;
            const char* a2 = last ? nA : cA + (size_t)(t + 2) * kstep; const char* b2 = last ? nB : cB + (size_t)(t + 2) * kstep;
            const char* a3 = a2 + kstep; const char* b3 = b2 + kstep;
            if (last && has_next) S.a_ready(nxt);
            if constexpr (SP2) {
            PG8_LDB(B0, 0, 0); PG8_LDB(B1, 0, 1); PG8_SCHED; PG8_LDA(At, 0, 0); PG8_STAGE(PG8_SA(1, 1), a1 + hstep, voffA);
            PG8_WAIT_V(8); PG8_WAIT_L(0); PG8_BAR; PG8_MMA(0, 0, At, B0); PG8_MMA(0, 1, At, B1); PG8_BAR; PG8_SCHED;
            PG8_LDA(At, 0, 1); PG8_STAGE(PG8_SB(0, 0), b2, voffB); PG8_STAGE(PG8_SB(0, 1), b2 + hstep, voffB); PG8_STAGE(PG8_SA(0, 0), a2, voffA);
            PG8_WAIT_V(8); PG8_WAIT_L(0); PG8_BAR; PG8_MMA(1, 0, At, B0); PG8_MMA(1, 1, At, B1); PG8_BAR; PG8_SCHED;
            PG8_LDB(B0, 1, 0); PG8_LDB(B1, 1, 1); PG8_SCHED; PG8_LDA(At, 1, 0); PG8_STAGE(PG8_SA(0, 1), a2 + hstep, voffA);
            PG8_WAIT_V(8); PG8_WAIT_L(0); PG8_BAR; PG8_MMA(0, 0, At, B0); PG8_MMA(0, 1, At, B1); PG8_BAR; PG8_SCHED;
            PG8_LDA(At, 1, 1); PG8_STAGE(PG8_SB(1, 0), b3, voffB); PG8_STAGE(PG8_SB(1, 1), b3 + hstep, voffB); PG8_STAGE(PG8_SA(1, 0), a3, voffA);
            PG8_WAIT_V(8); PG8_WAIT_L(0); PG8_BAR; PG8_MMA(1, 0, At, B0); PG8_MMA(1, 1, At, B1); PG8_BAR; PG8_SCHED;
            } else {
            PG8_LDB(B0, 0, 0); PG8_SCHED; PG8_LDA(At, 0, 0); PG8_STAGE(PG8_SA(1, 1), a1 + hstep, voffA);
            PG8_WAIT_L(8); PG8_BAR; PG8_WAIT_L(0); PG8_MMA(0, 0, At, B0); PG8_BAR; PG8_SCHED;
            PG8_LDB(B1, 0, 1); PG8_STAGE(PG8_SB(0, 0), b2, voffB);
            PG8_BAR; PG8_WAIT_L(0); PG8_MMA(0, 1, At, B1); PG8_BAR;
            PG8_LDA(At, 0, 1); PG8_STAGE(PG8_SA(0, 0), a2, voffA);
            PG8_BAR; PG8_WAIT_L(0); PG8_MMA(1, 0, At, B0); PG8_BAR; PG8_SCHED;
            PG8_STAGE(PG8_SB(0, 1), b2 + hstep, voffB);
            PG8_WAIT_V(6); PG8_BAR; PG8_MMA(1, 1, At, B1); PG8_BAR;
            PG8_LDB(B0, 1, 0); PG8_SCHED; PG8_LDA(At, 1, 0); PG8_STAGE(PG8_SA(0, 1), a2 + hstep, voffA);
            PG8_WAIT_L(8); PG8_BAR; PG8_WAIT_L(0); PG8_MMA(0, 0, At, B0); PG8_BAR; PG8_SCHED;
            PG8_LDB(B1, 1, 1); PG8_STAGE(PG8_SB(1, 0), b3, voffB);
            PG8_BAR; PG8_WAIT_L(0); PG8_MMA(0, 1, At, B1); PG8_BAR;
            PG8_LDA(At, 1, 1); PG8_STAGE(PG8_SA(1, 0), a3, voffA);
            PG8_BAR; PG8_WAIT_L(0); PG8_MMA(1, 0, At, B0); PG8_BAR; PG8_SCHED;
            PG8_STAGE(PG8_SB(1, 1), b3 + hstep, voffB);
            PG8_WAIT_V(6); PG8_BAR; PG8_MMA(1, 1, At, B1); PG8_BAR;
            }
        }
        if constexpr (ALIGN_EPI) { if (wr == 0) PG8_BAR; }
        if constexpr (!Epi::AFTER_DRAIN) { E(acc, cur, wr, wc, fr, fq); S.done(cur); }
        if (!has_next) break;
#pragma unroll
        for (int a = 0; a < 2; ++a)
#pragma unroll
            for (int b = 0; b < 2; ++b)
#pragma unroll
                for (int m = 0; m < 4; ++m)
#pragma unroll
                    for (int n = 0; n < 2; ++n) acc[a][b][m][n] = (f32x4){0.f, 0.f, 0.f, 0.f};
        cur = nxt; cA = nA; cB = nB; ++ui;
        if constexpr (ALIGN_EPI) { if (wr == 1) PG8_BAR; }
    }
    PG8_WAIT_V(0);
    if constexpr (!ALIGN_EPI) { if (wr == 0) PG8_BAR; }
    PG8_BAR;
    if constexpr (Epi::AFTER_DRAIN) { E.fused(acc, cur, wr, wc, fr, fq, lds, wid, lane); S.done(cur); }
#undef PG8_SA
#undef PG8_SB
#undef PG8_STAGE
#undef PG8_LDA
#undef PG8_LDB
#undef PG8_MMA
#undef PG8_WAIT_V
#undef PG8_WAIT_L
#undef PG8_BAR
#undef PG8_SCHED
}
}

#define LAS __attribute__((address_space(3)))
#define DI __device__ __forceinline__
typedef unsigned short bf16_t;
typedef short bf16x8 __attribute__((ext_vector_type(8)));
typedef short s16x4 __attribute__((ext_vector_type(4)));
typedef short v4i16_t __attribute__((ext_vector_type(4)));
typedef float f32x4 __attribute__((ext_vector_type(4)));
typedef float f32x2_t __attribute__((ext_vector_type(2)));
typedef __bf16 bf16x2_t __attribute__((ext_vector_type(2)));
typedef unsigned u32x4 __attribute__((ext_vector_type(4)));
typedef unsigned u32x2 __attribute__((ext_vector_type(2)));

constexpr int NTOK = 65536, DM = 1024, SEQ = 8192;
constexpr size_t MiB = 1u << 20;
constexpr size_t WS_MOD = 0;
constexpr size_t WS_INVF = 256 * 1024;
constexpr size_t WS_W0IN = 1 * MiB, WS_W0OUT = 13 * MiB, WS_W1IN = 17 * MiB, WS_W1OUT = 33 * MiB;
constexpr size_t WS_SSQ = 37 * MiB;
constexpr size_t WS_H = 48 * MiB;
constexpr size_t WS_ACT = 176 * MiB;
constexpr size_t WS_Q0 = WS_ACT, WS_K0 = WS_ACT + 128 * MiB, WS_V0 = WS_ACT + 256 * MiB;
constexpr size_t WS_Q1 = WS_ACT, WS_K1 = WS_ACT + 256 * MiB, WS_V1 = WS_ACT + 512 * MiB;
constexpr size_t WS_END = WS_ACT + 768 * MiB;
constexpr int LDS_BYTES = 147456;
constexpr float EPSF = 1e-6f;

DI unsigned pkbf(float lo, float hi) { f32x2_t v = {lo, hi}; bf16x2_t b = __builtin_convertvector(v, bf16x2_t); return __builtin_bit_cast(unsigned, b); }
DI float bflo(unsigned u) { return __builtin_bit_cast(float, u << 16); }
DI float bfhi(unsigned u) { return __builtin_bit_cast(float, u & 0xffff0000u); }
DI float ex2(float x) { return __builtin_amdgcn_exp2f(x); }
DI f32x4 mfma16(bf16x8 a, bf16x8 b, f32x4 c) { return __builtin_amdgcn_mfma_f32_16x16x32_bf16(a, b, c, 0, 0, 0); }
DI s16x4 tr_read(const LAS unsigned char* p) { return __builtin_bit_cast(s16x4, __builtin_amdgcn_ds_read_tr16_b64_v4i16((LAS v4i16_t*)p)); }
DI bf16x8 cat4(s16x4 lo, s16x4 hi) { return __builtin_shufflevector(lo, hi, 0, 1, 2, 3, 4, 5, 6, 7); }
DI bf16x8 pack8(f32x4 a, f32x4 b) { u32x4 p; p.x = pkbf(a[0], a[1]); p.y = pkbf(a[2], a[3]); p.z = pkbf(b[0], b[1]); p.w = pkbf(b[2], b[3]); return __builtin_bit_cast(bf16x8, p); }
DI float silu_f(float g) { return g * __builtin_amdgcn_rcpf(1.f + ex2(-1.4426950408889634f * g)); }
DI float wave_sum(float v) {
#pragma unroll
    for (int o = 1; o < 64; o <<= 1) v += __shfl_xor(v, o);
    return v;
}
DI float ssq8(u32x4 v) { float s = 0.f;
#pragma unroll
    for (int e = 0; e < 4; ++e) { const float a = bflo(v[e]), b = bfhi(v[e]); s += a * a + b * b; }
    return s; }

typedef const f32x4 (&AccRef)[2][2][4][2];
constexpr float INV2PI_HI = 0.15915493667125702f, INV2PI_LO = 6.4206382432985265e-09f;

struct EpiA0 {
    static constexpr bool PERM = true, AFTER_DRAIN = false;
    bf16_t *Q, *K, *V; const int* pos; const float* invf;
    DI void operator()(AccRef acc, const pg8::Unit& u, int wr, int wc, int fr, int fq) const {
        const int row0 = u.pm * 256 + wr * 64 + fr;
        if (u.pn < 8) {
            bf16_t* base = (u.pn < 4 ? Q : K) + (u.pn & 3) * 256;
            const float sc = u.pn < 4 ? 1.f : 0.0625f;
            const int cl = wc * 32 + 8 * fq;
            const f32x4 f0 = *(const f32x4*)(invf + cl), f1 = *(const f32x4*)(invf + cl + 4);
#pragma unroll
            for (int ai = 0; ai < 2; ++ai)
#pragma unroll
                for (int m = 0; m < 4; ++m) {
                    const int row = row0 + ai * 128 + m * 16;
                    const float p = (float)pos[row];
                    float o1[8], o2[8];
#pragma unroll
                    for (int n = 0; n < 2; ++n)
#pragma unroll
                        for (int i = 0; i < 4; ++i) {
                            const float ang = p * (n == 0 ? f0[i] : f1[i]);
                            const float hi = ang * INV2PI_HI;
                            float lo = __builtin_fmaf(ang, INV2PI_HI, -hi); lo = __builtin_fmaf(ang, INV2PI_LO, lo);
                            const float r = __builtin_amdgcn_fractf(hi) + lo;
                            const float s = __builtin_amdgcn_sinf(r), c = __builtin_amdgcn_cosf(r);
                            const float t1 = acc[ai][0][m][n][i], t2 = acc[ai][1][m][n][i];
                            o1[4 * n + i] = (t1 * c - t2 * s) * sc; o2[4 * n + i] = (t1 * s + t2 * c) * sc;
                        }
                    bf16_t* rp = base + (size_t)row * 1024 + cl;
                    u32x4 w1, w2;
                    w1.x = pkbf(o1[0], o1[1]); w1.y = pkbf(o1[2], o1[3]); w1.z = pkbf(o1[4], o1[5]); w1.w = pkbf(o1[6], o1[7]);
                    w2.x = pkbf(o2[0], o2[1]); w2.y = pkbf(o2[2], o2[3]); w2.z = pkbf(o2[4], o2[5]); w2.w = pkbf(o2[6], o2[7]);
                    *(u32x4*)rp = w1; *(u32x4*)(rp + 128) = w2;
                }
        } else {
            const int col0 = (u.pn - 8) * 256 + wc * 32 + 8 * fq;
#pragma unroll
            for (int ai = 0; ai < 2; ++ai)
#pragma unroll
                for (int m = 0; m < 4; ++m) {
                    bf16_t* rp = V + (size_t)(row0 + ai * 128 + m * 16) * 2048 + col0;
#pragma unroll
                    for (int bj = 0; bj < 2; ++bj) { const f32x4 v0 = acc[ai][bj][m][0], v1 = acc[ai][bj][m][1];
                        u32x4 w; w.x = pkbf(v0[0], v0[1]); w.y = pkbf(v0[2], v0[3]); w.z = pkbf(v1[0], v1[1]); w.w = pkbf(v1[2], v1[3]);
                        *(u32x4*)(rp + bj * 128) = w; }
                }
        }
    }
};

struct EpiA1 {
    static constexpr bool PERM = true, AFTER_DRAIN = false;
    bf16_t* Q;
    DI void operator()(AccRef acc, const pg8::Unit& u, int wr, int wc, int fr, int fq) const {
        const int row0 = u.pm * 256 + wr * 64 + fr;
        bf16_t* base = Q + (size_t)(u.pn >> 3) * ((size_t)NTOK * 2048);
        const int col0 = (u.pn & 7) * 256 + wc * 32 + 8 * fq;
#pragma unroll
        for (int ai = 0; ai < 2; ++ai)
#pragma unroll
            for (int m = 0; m < 4; ++m) {
                bf16_t* rp = base + (size_t)(row0 + ai * 128 + m * 16) * 2048 + col0;
#pragma unroll
                for (int bj = 0; bj < 2; ++bj) { const f32x4 v0 = acc[ai][bj][m][0], v1 = acc[ai][bj][m][1];
                    u32x4 w; w.x = pkbf(v0[0], v0[1]); w.y = pkbf(v0[2], v0[3]); w.z = pkbf(v1[0], v1[1]); w.w = pkbf(v1[2], v1[3]);
                    *(u32x4*)(rp + bj * 128) = w; }
            }
    }
};

template <int L> struct EpiG {
    static constexpr bool PERM = true, AFTER_DRAIN = false;
    bf16_t* O; const float* ssq; const float* gn;
    DI void operator()(AccRef acc, const pg8::Unit& u, int wr, int wc, int fr, int fq) const {
        const int row0 = u.pm * 256 + wr * 64 + fr;
        const int col0 = u.pn * 256 + wc * 32 + 8 * fq, head = u.pn >> 1;
        float gnv[2][8];
#pragma unroll
        for (int bj = 0; bj < 2; ++bj)
#pragma unroll
            for (int e = 0; e < 8; ++e) gnv[bj][e] = (L == 0) ? gn[col0 + bj * 128 + e] : 1.f;
#pragma unroll
        for (int ai = 0; ai < 2; ++ai)
#pragma unroll
            for (int m = 0; m < 4; ++m) {
                const int row = row0 + ai * 128 + m * 16;
                float rstd = 1.f;
                if (L == 0) { const float* sp = ssq + ((size_t)row * 4 + head) * 8; const f32x4 s0 = *(const f32x4*)sp, s1 = *(const f32x4*)(sp + 4);
                    const float tot = ((s0[0] + s0[1]) + (s0[2] + s0[3])) + ((s1[0] + s1[1]) + (s1[2] + s1[3]));
                    rstd = __builtin_amdgcn_rsqf(tot * (1.f / 512.f) + EPSF); }
                bf16_t* rp = O + (size_t)row * 2048 + col0;
#pragma unroll
                for (int bj = 0; bj < 2; ++bj) {
                    const u32x4 ov = *(const u32x4*)(rp + bj * 128);
                    const f32x4 g0 = acc[ai][bj][m][0], g1 = acc[ai][bj][m][1];
                    float r[8];
#pragma unroll
                    for (int e = 0; e < 4; ++e) { const float ga = (e < 2 ? g0[2 * e] : g1[2 * e - 4]), gb = (e < 2 ? g0[2 * e + 1] : g1[2 * e - 3]);
                        r[2 * e] = bflo(ov[e]) * silu_f(ga) * (rstd * gnv[bj][2 * e]); r[2 * e + 1] = bfhi(ov[e]) * silu_f(gb) * (rstd * gnv[bj][2 * e + 1]); }
                    u32x4 w; w.x = pkbf(r[0], r[1]); w.y = pkbf(r[2], r[3]); w.z = pkbf(r[4], r[5]); w.w = pkbf(r[6], r[7]);
                    *(u32x4*)(rp + bj * 128) = w;
                }
            }
    }
};

struct EpiOut {
    static constexpr bool PERM = true, AFTER_DRAIN = false;
    const float* xin; float* xout; const float* gate;
    DI void operator()(AccRef acc, const pg8::Unit& u, int wr, int wc, int fr, int fq) const {
        const int row0 = u.pm * 256 + wr * 64 + fr;
        const int col0 = u.pn * 256 + wc * 32 + 8 * fq;
        const float* gp = gate + (size_t)(u.pm >> 5) * 3072 + col0;
        f32x4 gv[2][2];
#pragma unroll
        for (int bj = 0; bj < 2; ++bj) { gv[bj][0] = *(const f32x4*)(gp + bj * 128); gv[bj][1] = *(const f32x4*)(gp + bj * 128 + 4); }
#pragma unroll
        for (int ai = 0; ai < 2; ++ai)
#pragma unroll
            for (int m = 0; m < 4; ++m) {
                const size_t off = (size_t)(row0 + ai * 128 + m * 16) * 1024 + col0;
#pragma unroll
                for (int bj = 0; bj < 2; ++bj) {
                    const f32x4 x0 = *(const f32x4*)(xin + off + bj * 128), x1 = *(const f32x4*)(xin + off + bj * 128 + 4);
                    *(f32x4*)(xout + off + bj * 128) = x0 + gv[bj][0] * acc[ai][bj][m][0];
                    *(f32x4*)(xout + off + bj * 128 + 4) = x1 + gv[bj][1] * acc[ai][bj][m][1];
                }
            }
    }
};

DI unsigned f2bf(float f) { unsigned u = __builtin_bit_cast(unsigned, f); return (u + 0x7fffu + ((u >> 16) & 1u)) >> 16; }
DI unsigned pk2(float lo, float hi) { return f2bf(lo) | (f2bf(hi) << 16); }
DI void p0_transpose_item(const float* W, int K, int N, bf16_t* WT, LAS float* scr, int item, int lane) {
    const int nblk = N / 32, kb = item / nblk, nb = item % nblk, k0 = 64 * kb, n0 = 32 * nb;
#pragma unroll 8
    for (int i = 0; i < 32; ++i) { const int kk = 2 * i + (lane >> 5); scr[kk * 33 + (lane & 31)] = W[(size_t)(k0 + kk) * N + n0 + (lane & 31)]; }
    asm volatile("s_waitcnt lgkmcnt(0)" ::: "memory");
    const int c = lane & 7;
#pragma unroll
    for (int j = 0; j < 4; ++j) { const int n = (lane >> 3) + 8 * j; const LAS float* s = scr + (8 * c) * 33 + n;
        u32x4 o; o.x = pk2(s[0 * 33], s[1 * 33]); o.y = pk2(s[2 * 33], s[3 * 33]); o.z = pk2(s[4 * 33], s[5 * 33]); o.w = pk2(s[6 * 33], s[7 * 33]);
        *(u32x4*)(WT + (size_t)(n0 + n) * K + k0 + 8 * c) = o; }
    asm volatile("s_waitcnt lgkmcnt(0)" ::: "memory");
}

DI void p0_phase(LAS unsigned char* lds, const float* cvec, const float* ada_w, const float* ada_b, const float* w0in, const float* w0out, const float* w1in, const float* w1out,
                 unsigned char* ws, int bid, int G) {
    const int tid = threadIdx.x, lane = tid & 63, w = __builtin_amdgcn_readfirstlane(tid >> 6);
    float* mod = (float*)(ws + WS_MOD);
    if (bid == G - 1 && tid < 128) { float* invf = (float*)(ws + WS_INVF); invf[tid] = 1.0f / powf(10000.0f, (float)(2 * tid) / 256.0f); }
    LAS float* cond = (LAS float*)lds;
    LAS float* red = (LAS float*)(lds + 32768);
    if (bid < 96) {
        for (int i = tid; i < 8192; i += 512) { const float v = cvec[i]; cond[i] = v / (1.f + expf(-v)); }
        __syncthreads();
    }
    for (int mi = bid; mi < 96; mi += G) {
        const int n0 = mi * 64, layer = n0 / 3072, nn = n0 % 3072 + lane;
        const float* wp = ada_w + (size_t)layer * 1024 * 3072 + nn;
        float acc[8];
#pragma unroll
        for (int b = 0; b < 8; ++b) acc[b] = 0.f;
#pragma unroll 8
        for (int kk = 0; kk < 128; ++kk) { const int k = w * 128 + kk; const float wv = wp[(size_t)k * 3072];
#pragma unroll
            for (int b = 0; b < 8; ++b) acc[b] += cond[b * 1024 + k] * wv; }
#pragma unroll
        for (int b = 0; b < 8; ++b) red[(w * 8 + b) * 64 + lane] = acc[b];
        __syncthreads();
        { const int b = tid >> 6; float s = 0.f;
#pragma unroll
          for (int ww = 0; ww < 8; ++ww) s += red[(ww * 8 + b) * 64 + lane];
          mod[((size_t)layer * 8 + b) * 3072 + nn] = s + ada_b[layer * 3072 + nn]; }
        __syncthreads();
    }
    __syncthreads();
    LAS float* scr = (LAS float*)(lds + 65536 + w * 8704);
    const int gw = bid * 8 + w, NGW = G * 8;
    constexpr int I0 = (1024 / 64) * (6144 / 32), I1 = (2048 / 64) * (1024 / 32), I2 = (1024 / 64) * (8192 / 32), I3 = I1;
    for (int it = gw; it < I0 + I1 + I2 + I3; it += NGW) {
        int r = it;
        if (r < I0) { p0_transpose_item(w0in, 1024, 6144, (bf16_t*)(ws + WS_W0IN), scr, r, lane); continue; } r -= I0;
        if (r < I1) { p0_transpose_item(w0out, 2048, 1024, (bf16_t*)(ws + WS_W0OUT), scr, r, lane); continue; } r -= I1;
        if (r < I2) { p0_transpose_item(w1in, 1024, 8192, (bf16_t*)(ws + WS_W1IN), scr, r, lane); continue; } r -= I2;
        p0_transpose_item(w1out, 2048, 1024, (bf16_t*)(ws + WS_W1OUT), scr, r, lane);
    }
}

DI void ln_phase(const float* xin, bf16_t* h, const float* ng, const float* modl, int gw, int NGW, int lane) {
    for (int m = gw; m < NTOK; m += NGW) {
        const int b = m >> 13;
        const float* xr = xin + (size_t)m * 1024;
        const float* sh = modl + (size_t)b * 3072; const float* scl = sh + 1024;
        f32x4 v[4];
        v[0] = *(const f32x4*)(xr + 8 * lane); v[1] = *(const f32x4*)(xr + 8 * lane + 4); v[2] = *(const f32x4*)(xr + 512 + 8 * lane); v[3] = *(const f32x4*)(xr + 512 + 8 * lane + 4);
        float ss = 0.f;
#pragma unroll
        for (int i = 0; i < 4; ++i) ss += (v[i][0] * v[i][0] + v[i][1] * v[i][1]) + (v[i][2] * v[i][2] + v[i][3] * v[i][3]);
        ss = wave_sum(ss);
        const float rstd = 1.0f / sqrtf(ss * (1.f / 1024.f) + EPSF);
        float o[16];
#pragma unroll
        for (int i = 0; i < 4; ++i) { const int c = (i >> 1) * 512 + 8 * lane + (i & 1) * 4;
            const f32x4 g = *(const f32x4*)(ng + c), s1 = *(const f32x4*)(scl + c), s0 = *(const f32x4*)(sh + c);
#pragma unroll
            for (int e = 0; e < 4; ++e) o[4 * i + e] = v[i][e] * rstd * g[e] * (1.f + s1[e]) + s0[e]; }
        u32x4 w0, w1;
        w0.x = pkbf(o[0], o[1]); w0.y = pkbf(o[2], o[3]); w0.z = pkbf(o[4], o[5]); w0.w = pkbf(o[6], o[7]);
        w1.x = pkbf(o[8], o[9]); w1.y = pkbf(o[10], o[11]); w1.z = pkbf(o[12], o[13]); w1.w = pkbf(o[14], o[15]);
        *(u32x4*)(h + (size_t)m * 1024 + 8 * lane) = w0; *(u32x4*)(h + (size_t)m * 1024 + 512 + 8 * lane) = w1;
    }
}

constexpr int R_QSTR = 528, R_KSTR = 544, R_VSTR = 160, R_PSTR = 144;
constexpr int R_QL = 0, R_KL = R_QL + 64 * R_QSTR, R_VL = R_KL + 64 * R_KSTR, R_PL = R_VL + 64 * R_VSTR, R_XL = R_PL + 64 * R_PSTR, R_SL = R_XL + 16384, R_END = R_SL + 1024;
static_assert(R_END <= LDS_BYTES, "retention LDS");

DI void ret_phase(LAS unsigned char* lds, const bf16_t* Q0, const bf16_t* K0, bf16_t* V0, float* ssq, int vcu, int G) {
    const int tid = threadIdx.x, lane = tid & 63, w = __builtin_amdgcn_readfirstlane(tid >> 6), fr = lane & 15, fq = lane >> 4;
    const int et = w & 3, dh = w >> 2;
    for (int it = vcu; it < 256; it += G) {
        const int bh = it >> 3, dvt = it & 7, b = bh >> 2, h = bh & 3;
        const float lg2 = log2f(1.0f - exp2f(-5.0f - (float)h));
        const float cd = exp2f(lg2 * 64.f);
        float kd[2][8];
#pragma unroll
        for (int s = 0; s < 2; ++s)
#pragma unroll
            for (int jj = 0; jj < 8; ++jj) kd[s][jj] = exp2f(lg2 * (float)(63 - (32 * s + 16 * (jj >> 2) + 4 * fq + (jj & 3))));
        const int ct_own = 2 * dh, ct_oth = 2 * (1 - dh);
        float qd[2];
#pragma unroll
        for (int i = 0; i < 2; ++i) qd[i] = exp2f(lg2 * (float)(16 * (ct_own + i) + fr + 1));
        f32x4 st[8];
#pragma unroll
        for (int t = 0; t < 8; ++t) st[t] = (f32x4){0.f, 0.f, 0.f, 0.f};
        const size_t tok0 = (size_t)b * SEQ;
        u32x4 qr[4], kr[4], vr;
#define R_ISSUE(j) do { _Pragma("unroll") for (int i_ = 0; i_ < 4; ++i_) { const int ch_ = tid + 512 * i_; const size_t g_ = (tok0 + (size_t)(j) * 64 + (ch_ >> 5)) * 1024 + h * 256 + (ch_ & 31) * 8; \
            qr[i_] = *(const u32x4*)(Q0 + g_); kr[i_] = *(const u32x4*)(K0 + g_); } \
            vr = *(const u32x4*)(V0 + (tok0 + (size_t)(j) * 64 + (tid >> 3)) * 2048 + h * 512 + dvt * 64 + (tid & 7) * 8); } while (0)
#define R_WRITE() do { _Pragma("unroll") for (int i_ = 0; i_ < 4; ++i_) { const int ch_ = tid + 512 * i_; \
            *(LAS u32x4*)(lds + R_QL + (ch_ >> 5) * R_QSTR + (ch_ & 31) * 16) = qr[i_]; *(LAS u32x4*)(lds + R_KL + (ch_ >> 5) * R_KSTR + (ch_ & 31) * 16) = kr[i_]; } \
            *(LAS u32x4*)(lds + R_VL + (tid >> 3) * R_VSTR + (tid & 7) * 16) = vr; } while (0)
        R_ISSUE(0); R_WRITE(); __syncthreads();
        for (int j = 0; j < 128; ++j) {
            if (j + 1 < 128) R_ISSUE(j + 1);
            {
                const int kt = w & 3, ctp = w >> 2;
                f32x4 sc0 = (f32x4){0.f, 0.f, 0.f, 0.f}, sc1 = sc0;
                const LAS unsigned char* kp = lds + R_KL + (16 * kt + fr) * R_KSTR + fq * 16;
                const LAS unsigned char* qp = lds + R_QL + (32 * ctp + fr) * R_QSTR + fq * 16;
#pragma unroll
                for (int ks = 0; ks < 8; ++ks) {
                    const bf16x8 kf = *(const LAS bf16x8*)(kp + ks * 64), q0 = *(const LAS bf16x8*)(qp + ks * 64), q1 = *(const LAS bf16x8*)(qp + 16 * R_QSTR + ks * 64);
                    sc0 = mfma16(kf, q0, sc0); sc1 = mfma16(kf, q1, sc1);
                }
                const int c0 = 32 * ctp + fr, kbase = 16 * kt + 4 * fq;
                float p0[4], p1[4];
#pragma unroll
                for (int r = 0; r < 4; ++r) { const int d0 = c0 - (kbase + r), d1 = d0 + 16;
                    p0[r] = sc0[r] * ex2(lg2 * (float)(d0 < 0 ? -d0 : d0)); p1[r] = sc1[r] * ex2(lg2 * (float)(d1 < 0 ? -d1 : d1)); }
                u32x2 w0, w1; w0.x = pkbf(p0[0], p0[1]); w0.y = pkbf(p0[2], p0[3]); w1.x = pkbf(p1[0], p1[1]); w1.y = pkbf(p1[2], p1[3]);
                *(LAS u32x2*)(lds + R_PL + c0 * R_PSTR + kbase * 2) = w0; *(LAS u32x2*)(lds + R_PL + (c0 + 16) * R_PSTR + kbase * 2) = w1;
            }
            f32x4 own[2], oth[2];
#pragma unroll
            for (int i = 0; i < 2; ++i) { own[i] = (f32x4){0.f, 0.f, 0.f, 0.f}; oth[i] = own[i]; }
            {
                const LAS unsigned char* qo = lds + R_QL + (16 * ct_own + fr) * R_QSTR + (128 * dh + 4 * fq) * 2;
                const LAS unsigned char* qt = lds + R_QL + (16 * ct_oth + fr) * R_QSTR + (128 * dh + 4 * fq) * 2;
#pragma unroll
                for (int ksp = 0; ksp < 4; ++ksp) {
                    const bf16x8 a = pack8(st[2 * ksp], st[2 * ksp + 1]);
#pragma unroll
                    for (int i = 0; i < 2; ++i) {
                        const bf16x8 bo = cat4(*(const LAS s16x4*)(qo + i * 16 * R_QSTR + ksp * 64), *(const LAS s16x4*)(qo + i * 16 * R_QSTR + ksp * 64 + 32));
                        const bf16x8 bt = cat4(*(const LAS s16x4*)(qt + i * 16 * R_QSTR + ksp * 64), *(const LAS s16x4*)(qt + i * 16 * R_QSTR + ksp * 64 + 32));
                        own[i] = mfma16(a, bo, own[i]); oth[i] = mfma16(a, bt, oth[i]);
                    }
                }
#pragma unroll
                for (int i = 0; i < 2; ++i) *(LAS f32x4*)(lds + R_XL + ((w * 2 + i) * 64 + lane) * 16) = oth[i];
            }
            __syncthreads();
            {
                const int pw = et + 4 * (1 - dh);
#pragma unroll
                for (int i = 0; i < 2; ++i) { const f32x4 o2 = *(const LAS f32x4*)(lds + R_XL + ((pw * 2 + i) * 64 + lane) * 16); own[i] = (own[i] + o2) * qd[i]; }
            }
            bf16x8 vf[2];
#pragma unroll
            for (int s = 0; s < 2; ++s) {
                const LAS unsigned char* va = lds + R_VL + (32 * s + 4 * fq + (fr >> 2)) * R_VSTR + (16 * et + 4 * (fr & 3)) * 2;
                vf[s] = cat4(tr_read(va), tr_read(va + 16 * R_VSTR));
#pragma unroll
                for (int i = 0; i < 2; ++i) { const LAS unsigned char* pa = lds + R_PL + (16 * (ct_own + i) + fr) * R_PSTR + (32 * s + 4 * fq) * 2;
                    own[i] = mfma16(vf[s], cat4(*(const LAS s16x4*)pa, *(const LAS s16x4*)(pa + 32)), own[i]); }
            }
#pragma unroll
            for (int i = 0; i < 2; ++i) {
                const int c = 16 * (ct_own + i) + fr;
                u32x2 ow; ow.x = pkbf(own[i][0], own[i][1]); ow.y = pkbf(own[i][2], own[i][3]);
                *(u32x2*)(V0 + (tok0 + (size_t)j * 64 + c) * 2048 + h * 512 + dvt * 64 + 16 * et + 4 * fq) = ow;
                float sq = (own[i][0] * own[i][0] + own[i][1] * own[i][1]) + (own[i][2] * own[i][2] + own[i][3] * own[i][3]);
                sq += __shfl_xor(sq, 16); sq += __shfl_xor(sq, 32);
                if (fq == 0) *(LAS float*)(lds + R_SL + (et * 64 + c) * 4) = sq;
            }
#pragma unroll
            for (int t = 0; t < 8; ++t) st[t] = st[t] * cd;
#pragma unroll
            for (int s = 0; s < 2; ++s) {
                const u32x4 vu = __builtin_bit_cast(u32x4, vf[s]); u32x4 vsu;
#pragma unroll
                for (int e = 0; e < 4; ++e) vsu[e] = pkbf(bflo(vu[e]) * kd[s][2 * e], bfhi(vu[e]) * kd[s][2 * e + 1]);
                const bf16x8 vs = __builtin_bit_cast(bf16x8, vsu);
                const LAS unsigned char* ka = lds + R_KL + (32 * s + 4 * fq + (fr >> 2)) * R_KSTR + (128 * dh + 4 * (fr & 3)) * 2;
#pragma unroll
                for (int t = 0; t < 8; ++t) st[t] = mfma16(cat4(tr_read(ka + t * 32), tr_read(ka + t * 32 + 16 * R_KSTR)), vs, st[t]);
            }
            __syncthreads();
            if (tid < 64) { const LAS float* sl = (const LAS float*)(lds + R_SL) + tid;
                ssq[((tok0 + (size_t)j * 64 + tid) * 4 + h) * 8 + dvt] = (sl[0] + sl[64]) + (sl[128] + sl[192]); }
            if (j + 1 < 128) R_WRITE();
            __syncthreads();
        }
#undef R_ISSUE
#undef R_WRITE
    }
}

constexpr int A_KSTR = 272, A_VSTR = 288, A_KT = 64 * A_KSTR, A_VT = 64 * A_VSTR, A_BUF = A_KT + A_VT, A_TAB = 2 * A_BUF, A_END = A_TAB + 1088;
static_assert(A_END <= LDS_BYTES, "attention LDS");
constexpr float LOG2E = 1.4426950408889634f;

DI void att_phase(LAS unsigned char* lds, bf16_t* Q1, const bf16_t* K1, const bf16_t* V1, const float* qg, const float* kg, const float* rel, int vcu, int G) {
    const int tid = threadIdx.x, lane = tid & 63, w = __builtin_amdgcn_readfirstlane(tid >> 6), fr = lane & 15, fq = lane >> 4;
    const int lrow = tid >> 4, lcc = tid & 15;
    float kgv[8];
#pragma unroll
    for (int e = 0; e < 8; ++e) kgv[e] = kg[lcc * 8 + e];
    LAS float* tab = (LAS float*)(lds + A_TAB);
    for (int it = vcu; it < 4096; it += G) {
        const int b = it >> 9, h = (it >> 5) & 15, jg = it & 31;
        const int jw = 4 * jg + (w >> 1), qoff = (w & 1) * 32;
        const size_t qrow0 = (size_t)b * SEQ + (size_t)jw * 64 + qoff;
        const int kc_lo = (4 * jg - 8) > 0 ? (4 * jg - 8) : 0, nst = 4 * jg + 4 - kc_lo;
        u32x4 kr0, kr1, vr0, vr1;
#define A_ISSUE(kc) do { const size_t g_ = ((size_t)b * SEQ + (size_t)(kc) * 64 + lrow) * 2048 + h * 128 + lcc * 8; \
            kr0 = *(const u32x4*)(K1 + g_); kr1 = *(const u32x4*)(K1 + g_ + 32 * 2048); vr0 = *(const u32x4*)(V1 + g_); vr1 = *(const u32x4*)(V1 + g_ + 32 * 2048); } while (0)
#define A_WRITE(buf) do { float s0_ = ssq8(kr0), s1_ = ssq8(kr1); \
            _Pragma("unroll") for (int o_ = 1; o_ < 16; o_ <<= 1) { s0_ += __shfl_xor(s0_, o_); s1_ += __shfl_xor(s1_, o_); } \
            const float r0_ = __builtin_amdgcn_rsqf(s0_ * (1.f / 128.f) + EPSF), r1_ = __builtin_amdgcn_rsqf(s1_ * (1.f / 128.f) + EPSF); \
            u32x4 k0_, k1_; \
            _Pragma("unroll") for (int e_ = 0; e_ < 4; ++e_) { k0_[e_] = pkbf(bflo(kr0[e_]) * r0_ * kgv[2 * e_], bfhi(kr0[e_]) * r0_ * kgv[2 * e_ + 1]); \
                k1_[e_] = pkbf(bflo(kr1[e_]) * r1_ * kgv[2 * e_], bfhi(kr1[e_]) * r1_ * kgv[2 * e_ + 1]); } \
            LAS unsigned char* bb_ = lds + (buf) * A_BUF; \
            *(LAS u32x4*)(bb_ + lrow * A_KSTR + lcc * 16) = k0_; *(LAS u32x4*)(bb_ + (lrow + 32) * A_KSTR + lcc * 16) = k1_; \
            *(LAS u32x4*)(bb_ + A_KT + lrow * A_VSTR + lcc * 16) = vr0; *(LAS u32x4*)(bb_ + A_KT + (lrow + 32) * A_VSTR + lcc * 16) = vr1; } while (0)
        A_ISSUE(kc_lo);
        if (tid < 257) tab[tid] = rel[h * 257 + tid] * LOG2E;
        bf16x8 Qf[2][4];
        {
            const float qsc = 0.08838834764831845f * LOG2E;
#pragma unroll
            for (int qt = 0; qt < 2; ++qt) {
                u32x4 raw[4]; float ss = 0.f;
                const bf16_t* qp = Q1 + (qrow0 + 16 * qt + fr) * 2048 + h * 128 + 8 * fq;
#pragma unroll
                for (int ks = 0; ks < 4; ++ks) { raw[ks] = *(const u32x4*)(qp + 32 * ks); ss += ssq8(raw[ks]); }
                ss += __shfl_xor(ss, 16); ss += __shfl_xor(ss, 32);
                const float rs = __builtin_amdgcn_rsqf(ss * (1.f / 128.f) + EPSF) * qsc;
#pragma unroll
                for (int ks = 0; ks < 4; ++ks) {
                    const f32x4 g0 = *(const f32x4*)(qg + 32 * ks + 8 * fq), g1 = *(const f32x4*)(qg + 32 * ks + 8 * fq + 4);
                    u32x4 pq;
                    pq.x = pkbf(bflo(raw[ks].x) * rs * g0[0], bfhi(raw[ks].x) * rs * g0[1]); pq.y = pkbf(bflo(raw[ks].y) * rs * g0[2], bfhi(raw[ks].y) * rs * g0[3]);
                    pq.z = pkbf(bflo(raw[ks].z) * rs * g1[0], bfhi(raw[ks].z) * rs * g1[1]); pq.w = pkbf(bflo(raw[ks].w) * rs * g1[2], bfhi(raw[ks].w) * rs * g1[3]);
                    Qf[qt][ks] = __builtin_bit_cast(bf16x8, pq);
                }
            }
        }
        f32x4 O[8][2];
#pragma unroll
        for (int nt = 0; nt < 8; ++nt) { O[nt][0] = (f32x4){0.f, 0.f, 0.f, 0.f}; O[nt][1] = O[nt][0]; }
        float mrun[2] = {-1e30f, -1e30f}, lsum[2] = {0.f, 0.f};
        A_WRITE(0);
        __syncthreads();
        for (int t = 0; t < nst; ++t) {
            const int kc = kc_lo + t;
            if (t + 1 < nst) A_ISSUE(kc + 1);
            const int delta = jw - kc;
            if (delta >= 0 && delta <= 8) {
                const LAS unsigned char* kb = lds + (t & 1) * A_BUF;
                const LAS unsigned char* vb = kb + A_KT;
                f32x4 s[4][2];
#pragma unroll
                for (int kt = 0; kt < 4; ++kt) {
                    bf16x8 kf[4];
#pragma unroll
                    for (int ks = 0; ks < 4; ++ks) kf[ks] = *(const LAS bf16x8*)(kb + (16 * kt + fr) * A_KSTR + (32 * ks + 8 * fq) * 2);
#pragma unroll
                    for (int qt = 0; qt < 2; ++qt) { f32x4 c = (f32x4){0.f, 0.f, 0.f, 0.f};
#pragma unroll
                        for (int ks = 0; ks < 4; ++ks) c = mfma16(kf[ks], Qf[qt][ks], c);
                        s[kt][qt] = c; }
                }
                if (delta >= 3) { const float bc = tab[256];
#pragma unroll
                    for (int kt = 0; kt < 4; ++kt)
#pragma unroll
                        for (int qt = 0; qt < 2; ++qt) s[kt][qt] = s[kt][qt] + bc;
                } else {
#pragma unroll
                    for (int kt = 0; kt < 4; ++kt)
#pragma unroll
                        for (int qt = 0; qt < 2; ++qt)
#pragma unroll
                            for (int r = 0; r < 4; ++r) { int rl = (qoff + 16 * qt + fr) - (16 * kt + 4 * fq + r) + 64 * delta; rl = rl > 128 ? 128 : rl; s[kt][qt][r] += tab[rl + 128]; }
                }
#pragma unroll
                for (int qt = 0; qt < 2; ++qt) {
                    float mx = s[0][qt][0];
#pragma unroll
                    for (int kt = 0; kt < 4; ++kt)
#pragma unroll
                        for (int r = 0; r < 4; ++r) mx = fmaxf(mx, s[kt][qt][r]);
                    mx = fmaxf(mx, __shfl_xor(mx, 16)); mx = fmaxf(mx, __shfl_xor(mx, 32));
                    const float mn = fmaxf(mrun[qt], mx), alpha = ex2(mrun[qt] - mn); mrun[qt] = mn;
                    float ps = 0.f;
#pragma unroll
                    for (int kt = 0; kt < 4; ++kt)
#pragma unroll
                        for (int r = 0; r < 4; ++r) { const float p = ex2(s[kt][qt][r] - mn); s[kt][qt][r] = p; ps += p; }
                    lsum[qt] = lsum[qt] * alpha + ps;
#pragma unroll
                    for (int nt = 0; nt < 8; ++nt) O[nt][qt] = O[nt][qt] * alpha;
                }
#pragma unroll
                for (int s2 = 0; s2 < 2; ++s2) {
                    const bf16x8 pf0 = pack8(s[2 * s2][0], s[2 * s2 + 1][0]), pf1 = pack8(s[2 * s2][1], s[2 * s2 + 1][1]);
                    const LAS unsigned char* va = vb + (32 * s2 + 4 * fq + (fr >> 2)) * A_VSTR + 4 * (fr & 3) * 2;
#pragma unroll
                    for (int nt = 0; nt < 8; ++nt) {
                        const bf16x8 vfr = cat4(tr_read(va + nt * 32), tr_read(va + nt * 32 + 16 * A_VSTR));
                        O[nt][0] = mfma16(vfr, pf0, O[nt][0]); O[nt][1] = mfma16(vfr, pf1, O[nt][1]);
                    }
                }
            }
            if (t + 1 < nst) A_WRITE((t + 1) & 1);
            __syncthreads();
        }
#pragma unroll
        for (int qt = 0; qt < 2; ++qt) {
            float l = lsum[qt]; l += __shfl_xor(l, 16); l += __shfl_xor(l, 32);
            const float inv = 1.0f / l;
            bf16_t* op = Q1 + (qrow0 + 16 * qt + fr) * 2048 + h * 128 + 4 * fq;
#pragma unroll
            for (int nt = 0; nt < 8; ++nt) { u32x2 ow; ow.x = pkbf(O[nt][qt][0] * inv, O[nt][qt][1] * inv); ow.y = pkbf(O[nt][qt][2] * inv, O[nt][qt][3] * inv);
                *(u32x2*)(op + 16 * nt) = ow; }
        }
#undef A_ISSUE
#undef A_WRITE
    }
}

struct Args { const float* x; const float* c; const int* pos; const float* norm_g; const float* ada_w; const float* ada_b; const float* ret_w_in; const float* ret_gn; const float* ret_w_out;
              const float* att_w_in; const float* att_qg; const float* att_kg; const float* att_rel; const float* att_w_out; float* out; unsigned char* ws; int ph_lo, ph_hi; };
constexpr int NPH = 11;

__global__ void __launch_bounds__(512, 2) mega_fwd(Args a) {
    extern __shared__ __attribute__((aligned(16))) unsigned char lds_raw[];
    LAS unsigned char* lds = (LAS unsigned char*)lds_raw;
    cg::grid_group grid = cg::this_grid();
    const int tid = threadIdx.x, lane = tid & 63, w = __builtin_amdgcn_readfirstlane(tid >> 6);
    const int G = gridDim.x, bid = blockIdx.x;
    const int vcu = (G % 8 == 0) ? (bid % 8) * (G / 8) + bid / 8 : bid;
    const int gw = bid * 8 + w, NGW = G * 8;
    unsigned char* ws = a.ws;
    bf16_t* H = (bf16_t*)(ws + WS_H);
    const float* mod = (const float*)(ws + WS_MOD);
    const int lo = a.ph_lo, hi = a.ph_hi;
#define IN(k) (lo <= (k) && (k) < hi)
#define SEAM(k) do { if (IN(k) && IN((k) + 1)) grid.sync(); } while (0)
    if (IN(0)) p0_phase(lds, a.c, a.ada_w, a.ada_b, a.ret_w_in, a.ret_w_out, a.att_w_in, a.att_w_out, ws, bid, G);
    SEAM(0);
    if (IN(1)) ln_phase(a.x, H, a.norm_g, mod, gw, NGW, lane);
    SEAM(1);
    if (IN(2)) {
        pg8::Gemm g{H, (const bf16_t*)(ws + WS_W0IN), NTOK, 4096, 1024}; pg8::StaticOrder S; S.init(NTOK, 4096, G, bid);
        EpiA0 E{(bf16_t*)(ws + WS_Q0), (bf16_t*)(ws + WS_K0), (bf16_t*)(ws + WS_V0), a.pos, (const float*)(ws + WS_INVF)};
        pg8::gemm_phase<EpiA0, pg8::StaticOrder, true, true>(lds, g, S, E);
    }
    SEAM(2);
    if (IN(3)) ret_phase(lds, (const bf16_t*)(ws + WS_Q0), (const bf16_t*)(ws + WS_K0), (bf16_t*)(ws + WS_V0), (float*)(ws + WS_SSQ), vcu, G);
    SEAM(3);
    if (IN(4)) {
        pg8::Gemm g{H, (const bf16_t*)(ws + WS_W0IN) + (size_t)4096 * 1024, NTOK, 2048, 1024}; pg8::StaticOrder S; S.init(NTOK, 2048, G, bid);
        EpiG<0> E{(bf16_t*)(ws + WS_V0), (const float*)(ws + WS_SSQ), a.ret_gn};
        pg8::gemm_phase<EpiG<0>, pg8::StaticOrder, true, true>(lds, g, S, E);
    }
    SEAM(4);
    if (IN(5)) {
        pg8::Gemm g{(const bf16_t*)(ws + WS_V0), (const bf16_t*)(ws + WS_W0OUT), NTOK, 1024, 2048}; pg8::StaticOrder S; S.init(NTOK, 1024, G, bid);
        EpiOut E{a.x, a.out, mod + 2048};
        pg8::gemm_phase<EpiOut, pg8::StaticOrder, true, true>(lds, g, S, E);
    }
    SEAM(5);
    if (IN(6)) ln_phase(a.out, H, a.norm_g + 1024, mod + 8 * 3072, gw, NGW, lane);
    SEAM(6);
    if (IN(7)) {
        pg8::Gemm g{H, (const bf16_t*)(ws + WS_W1IN), NTOK, 6144, 1024}; pg8::StaticOrder S; S.init(NTOK, 6144, G, bid);
        EpiA1 E{(bf16_t*)(ws + WS_Q1)};
        pg8::gemm_phase<EpiA1, pg8::StaticOrder, true, true>(lds, g, S, E);
    }
    SEAM(7);
    if (IN(8)) att_phase(lds, (bf16_t*)(ws + WS_Q1), (const bf16_t*)(ws + WS_K1), (const bf16_t*)(ws + WS_V1), a.att_qg, a.att_kg, a.att_rel, vcu, G);
    SEAM(8);
    if (IN(9)) {
        pg8::Gemm g{H, (const bf16_t*)(ws + WS_W1IN) + (size_t)6144 * 1024, NTOK, 2048, 1024}; pg8::StaticOrder S; S.init(NTOK, 2048, G, bid);
        EpiG<1> E{(bf16_t*)(ws + WS_Q1), nullptr, nullptr};
        pg8::gemm_phase<EpiG<1>, pg8::StaticOrder, true, true>(lds, g, S, E);
    }
    SEAM(9);
    if (IN(10)) {
        pg8::Gemm g{(const bf16_t*)(ws + WS_Q1), (const bf16_t*)(ws + WS_W1OUT), NTOK, 1024, 2048}; pg8::StaticOrder S; S.init(NTOK, 1024, G, bid);
        EpiOut E{a.out, a.out, mod + 8 * 3072 + 2048};
        pg8::gemm_phase<EpiOut, pg8::StaticOrder, true, true>(lds, g, S, E);
    }
#undef IN
#undef SEAM
}

extern "C" void kernel_launch(void* const* d_in, const int* in_sizes, int n_in, void* d_out, int out_size, void* d_ws, size_t ws_size, hipStream_t stream) {
    static int grid = 0;
    if (grid == 0) {
        if (n_in != 14 || out_size != NTOK * DM || ws_size < WS_END) { fprintf(stderr, "kernel_launch: unexpected shapes (n_in %d out %d ws %zu need %zu)\n", n_in, out_size, ws_size, (size_t)WS_END); grid = -1; return; }
        int dev = 0, cus = 0, per_cu = 0;
        hipGetDevice(&dev);
        hipDeviceGetAttribute(&cus, hipDeviceAttributeMultiprocessorCount, dev);
        if (hipFuncSetAttribute((const void*)mega_fwd, hipFuncAttributeMaxDynamicSharedMemorySize, LDS_BYTES) != hipSuccess) { fprintf(stderr, "kernel_launch: hipFuncSetAttribute failed\n"); grid = -1; return; }
        if (hipOccupancyMaxActiveBlocksPerMultiprocessor(&per_cu, (const void*)mega_fwd, 512, LDS_BYTES) != hipSuccess || per_cu < 1) { fprintf(stderr, "kernel_launch: occupancy query says %d\n", per_cu); per_cu = 1; }
        (void)hipGetLastError();
        grid = cus * per_cu;
    }
    if (grid < 0) return;
    Args a{};
    a.x = (const float*)d_in[0]; a.c = (const float*)d_in[1]; a.pos = (const int*)d_in[2]; a.norm_g = (const float*)d_in[3]; a.ada_w = (const float*)d_in[4]; a.ada_b = (const float*)d_in[5];
    a.ret_w_in = (const float*)d_in[6]; a.ret_gn = (const float*)d_in[7]; a.ret_w_out = (const float*)d_in[8]; a.att_w_in = (const float*)d_in[9]; a.att_qg = (const float*)d_in[10];
    a.att_kg = (const float*)d_in[11]; a.att_rel = (const float*)d_in[12]; a.att_w_out = (const float*)d_in[13]; a.out = (float*)d_out; a.ws = (unsigned char*)d_ws;
#if MK_N_LAUNCHES == 1
    a.ph_lo = 0; a.ph_hi = NPH;
    void* args[] = {&a};
    hipError_t e = hipLaunchCooperativeKernel((const void*)mega_fwd, dim3(grid), dim3(512), args, LDS_BYTES, stream);
    if (e != hipSuccess) fprintf(stderr, "kernel_launch: cooperative launch failed: %s (grid %d)\n", hipGetErrorString(e), grid);
#else
    for (int p = 0; p < NPH; ++p) { a.ph_lo = p; a.ph_hi = p + 1; hipLaunchKernelGGL(mega_fwd, dim3(grid), dim3(512), LDS_BYTES, stream, a); }
#endif
}
```

```cpp
#include <hip/hip_runtime.h>
#include <hip/hip_cooperative_groups.h>
#include <cstdio>
#include <cstdint>
namespace cg = cooperative_groups;

#ifndef MK_N_LAUNCHES
#define MK_N_LAUNCHES 1
#endif
#ifndef PROBE_MASK
#define PROBE_MASK 0
#endif
#define PROBE_SHADOW 0

namespace pg8 {
#define PG8_LAS __attribute__((address_space(3)))
typedef unsigned short bf16_t;
typedef short bf16x8 __attribute__((ext_vector_type(8)));
typedef float f32x4 __attribute__((ext_vector_type(4)));
typedef unsigned u32x4 __attribute__((ext_vector_type(4)));
constexpr int BM = 256, BK = 64, HALF = 128, HTB = HALF * BK * 2  , STAGE_BYTES = 8 * HTB, NXCD = 8, WGM = 8;

__host__ __device__ __forceinline__ int lds_byte(int r, int c) { const int st = (r >> 4) * 2 + (c >> 5), rr = r & 15, cc = c & 31, ob = rr * 64 + cc * 2; return st * 1024 + (ob ^ (((ob >> 9) & 1) << 5)); }
__host__ __device__ __forceinline__ void stage_rc(int b, int& R, int& C) { const int st = b / 1024, sb = b % 1024, swz = sb ^ (((sb >> 9) & 1) << 5); R = (st >> 1) * 16 + swz / 64; C = (st & 1) * 32 + (swz % 64) / 2; }
__host__ __device__ __forceinline__ int perm32(int rho) { const int n = rho >> 4, i = rho & 15; return 8 * (i >> 2) + 4 * n + (i & 3); }

struct Unit { int pm, pn; };
struct Gemm { const bf16_t* A; const bf16_t* Bt; int M, N, K; };

struct StaticOrder {
    int nM, nN, nwg, G, c;
    __host__ __device__ void init(int M, int N, int G_, int c_) { nM = M / BM; nN = N / BM; nwg = nM * nN; G = G_; c = c_; }
    __host__ __device__ bool next(int i, Unit& u) const {
        const long L = (long)i * G + c; if (L >= nwg) return false;
        int wgid = (int)L; { const int q = nwg / NXCD, r = nwg % NXCD, xcd = wgid % NXCD, off = wgid / NXCD; wgid = (xcd < r ? xcd * (q + 1) : r * (q + 1) + (xcd - r) * q) + off; }
        const int nig = WGM * nN, gid = wgid / nig, fm = gid * WGM, gsz = (nM - fm) < WGM ? (nM - fm) : WGM;
        u.pm = fm + ((wgid % nig) % gsz); u.pn = (wgid % nig) / gsz; return true;
    }
    __device__ __forceinline__ void a_ready(const Unit&) const {}
    __device__ __forceinline__ void done(const Unit&) const {}
};

__device__ __forceinline__ unsigned cvt_pk_bf16(float lo, float hi) { unsigned r; asm volatile("v_cvt_pk_bf16_f32 %0, %1, %2" : "=v"(r) : "v"(lo), "v"(hi)); return r; }
template <class Epi, class Sched, bool ALIGN_EPI = false, bool SP2 = false>
__device__ __forceinline__ void gemm_phase(PG8_LAS unsigned char* lds, const Gemm g, const Sched& S, const Epi& E) {
    const int tid = threadIdx.x, wid = __builtin_amdgcn_readfirstlane(tid >> 6), lane = tid & 63, wr = wid >> 2, wc = wid & 3, fr = lane & 15, fq = lane >> 4;
    const int K = g.K, nt = K / BK;
    unsigned voffA[2], voffB[2];
#pragma unroll
    for (int i = 0; i < 2; ++i) { int R, C; stage_rc(tid * 16 + i * 8192, R, C); const int Rb = Epi::PERM ? ((R & ~31) + perm32(R & 31)) : R;
        voffA[i] = (unsigned)(R * K + C) * 2u; voffB[i] = (unsigned)(Rb * K + C) * 2u; }
    const size_t kstep = (size_t)(BK * 2);
    const size_t hstep = (size_t)HALF * K * 2;
    const size_t tstep = 2 * hstep;
    const unsigned ldsw = (unsigned)wid * 1024u;
    const int aoff = lds_byte(wr * 64 + fr, fq * 8), boff = lds_byte(wc * 32 + fr, fq * 8);
#define PG8_SA(b, h) (((b) * 2 + (h)) * HTB)
#define PG8_SB(b, h) ((4 + (b) * 2 + (h)) * HTB)
#define PG8_STAGE(bufoff, gbase, voff) do { _Pragma("unroll") for (int _i = 0; _i < 2; ++_i) \
        __builtin_amdgcn_global_load_lds((const unsigned*)((const char*)(gbase) + (voff)[_i]), (PG8_LAS unsigned*)(lds + (bufoff) + ldsw + _i * 8192), 16, 0, 0); } while (0)
#define PG8_LDA(dst, b, h) do { _Pragma("unroll") for (int m = 0; m < 4; ++m) _Pragma("unroll") for (int k = 0; k < 2; ++k) dst[m][k] = *(const PG8_LAS bf16x8*)(lds + PG8_SA(b, h) + aoff + m * 2048 + k * 1024); } while (0)
#define PG8_LDB(dst, b, h) do { _Pragma("unroll") for (int n = 0; n < 2; ++n) _Pragma("unroll") for (int k = 0; k < 2; ++k) dst[n][k] = *(const PG8_LAS bf16x8*)(lds + PG8_SB(b, h) + boff + n * 2048 + k * 1024); } while (0)
#define PG8_MMA(ai, bj, At, Bt) do { __builtin_amdgcn_s_setprio(1); _Pragma("unroll") for (int m = 0; m < 4; ++m) _Pragma("unroll") for (int n = 0; n < 2; ++n) _Pragma("unroll") for (int k = 0; k < 2; ++k) \
        acc[ai][bj][m][n] = __builtin_amdgcn_mfma_f32_16x16x32_bf16(Bt[n][k], At[m][k], acc[ai][bj][m][n], 0, 0, 0); __builtin_amdgcn_s_setprio(0); } while (0)
#define PG8_WAIT_V(n) asm volatile("s_waitcnt vmcnt(" #n ")" ::: "memory")
#define PG8_WAIT_L(n) asm volatile("s_waitcnt lgkmcnt(" #n ")" ::: "memory")
#define PG8_BAR __builtin_amdgcn_s_barrier()
#define PG8_SCHED __builtin_amdgcn_sched_barrier(0)
    Unit cur, nxt; int ui = 0;
    if (!S.next(0, cur)) return;
    f32x4 acc[2][2][4][2];
#pragma unroll
    for (int a = 0; a < 2; ++a)
#pragma unroll
        for (int b = 0; b < 2; ++b)
#pragma unroll
            for (int m = 0; m < 4; ++m)
#pragma unroll
                for (int n = 0; n < 2; ++n) acc[a][b][m][n] = (f32x4){0.f, 0.f, 0.f, 0.f};
    bf16x8 At[4][2], B0[2][2], B1[2][2];
    const char* cA = (const char*)g.A + (size_t)cur.pm * tstep; const char* cB = (const char*)g.Bt + (size_t)cur.pn * tstep;
    S.a_ready(cur);
    if constexpr (SP2) {
        PG8_STAGE(PG8_SB(0, 0), cB, voffB); PG8_STAGE(PG8_SB(0, 1), cB + hstep, voffB); PG8_STAGE(PG8_SA(0, 0), cA, voffA); PG8_STAGE(PG8_SA(0, 1), cA + hstep, voffA);
        if (wr == 1) PG8_BAR;
        PG8_WAIT_V(2); PG8_BAR;
        PG8_STAGE(PG8_SB(1, 0), cB + kstep, voffB); PG8_STAGE(PG8_SA(1, 0), cA + kstep, voffA); PG8_STAGE(PG8_SB(1, 1), cB + hstep + kstep, voffB);
        PG8_WAIT_V(6); PG8_BAR;
    } else {
        PG8_STAGE(PG8_SB(0, 0), cB, voffB); PG8_STAGE(PG8_SA(0, 0), cA, voffA); PG8_STAGE(PG8_SB(0, 1), cB + hstep, voffB); PG8_STAGE(PG8_SA(0, 1), cA + hstep, voffA);
        if (wr == 1) PG8_BAR;
        PG8_WAIT_V(4); PG8_BAR;
        PG8_STAGE(PG8_SB(1, 0), cB + kstep, voffB); PG8_STAGE(PG8_SA(1, 0), cA + kstep, voffA); PG8_STAGE(PG8_SB(1, 1), cB + hstep + kstep, voffB);
        PG8_WAIT_V(6); PG8_BAR;
    }
    for (;;) {
        const bool has_next = S.next(ui + 1, nxt);
        const char* nA = has_next ? (const char*)g.A + (size_t)nxt.pm * tstep : cA; const char* nB = has_next ? (const char*)g.Bt + (size_t)nxt.pn * tstep : cB;
        for (int t = 0; t < nt; t += 2) {
            const bool last = (t == nt - 2);
            const char* a1 = cA + (size_t)(t + 1) * kstep;
            const char* a2 = last ? nA : cA + (size_t)(t + 2) * kstep; const char* b2 = last ? nB : cB + (size_t)(t + 2) * kstep;
            const char* a3 = a2 + kstep; const char* b3 = b2 + kstep;
            if (last && has_next) S.a_ready(nxt);
            if constexpr (SP2) {
            PG8_LDB(B0, 0, 0); PG8_LDB(B1, 0, 1); PG8_SCHED; PG8_LDA(At, 0, 0); PG8_STAGE(PG8_SA(1, 1), a1 + hstep, voffA);
            PG8_WAIT_V(8); PG8_WAIT_L(0); PG8_BAR; PG8_MMA(0, 0, At, B0); PG8_MMA(0, 1, At, B1); PG8_BAR; PG8_SCHED;
            PG8_LDA(At, 0, 1); PG8_STAGE(PG8_SB(0, 0), b2, voffB); PG8_STAGE(PG8_SB(0, 1), b2 + hstep, voffB); PG8_STAGE(PG8_SA(0, 0), a2, voffA);
            PG8_WAIT_V(8); PG8_WAIT_L(0); PG8_BAR; PG8_MMA(1, 0, At, B0); PG8_MMA(1, 1, At, B1); PG8_BAR; PG8_SCHED;
            PG8_LDB(B0, 1, 0); PG8_LDB(B1, 1, 1); PG8_SCHED; PG8_LDA(At, 1, 0); PG8_STAGE(PG8_SA(0, 1), a2 + hstep, voffA);
            PG8_WAIT_V(8); PG8_WAIT_L(0); PG8_BAR; PG8_MMA(0, 0, At, B0); PG8_MMA(0, 1, At, B1); PG8_BAR; PG8_SCHED;
            PG8_LDA(At, 1, 1); PG8_STAGE(PG8_SB(1, 0), b3, voffB); PG8_STAGE(PG8_SB(1, 1), b3 + hstep, voffB); PG8_STAGE(PG8_SA(1, 0), a3, voffA);
            PG8_WAIT_V(8); PG8_WAIT_L(0); PG8_BAR; PG8_MMA(1, 0, At, B0); PG8_MMA(1, 1, At, B1); PG8_BAR; PG8_SCHED;
            } else {
            PG8_LDB(B0, 0, 0); PG8_SCHED; PG8_LDA(At, 0, 0); PG8_STAGE(PG8_SA(1, 1), a1 + hstep, voffA);
            PG8_WAIT_L(8); PG8_BAR; PG8_WAIT_L(0); PG8_MMA(0, 0, At, B0); PG8_BAR; PG8_SCHED;
            PG8_LDB(B1, 0, 1); PG8_STAGE(PG8_SB(0, 0), b2, voffB);
            PG8_BAR; PG8_WAIT_L(0); PG8_MMA(0, 1, At, B1); PG8_BAR;
            PG8_LDA(At, 0, 1); PG8_STAGE(PG8_SA(0, 0), a2, voffA);
            PG8_BAR; PG8_WAIT_L(0); PG8_MMA(1, 0, At, B0); PG8_BAR; PG8_SCHED;
            PG8_STAGE(PG8_SB(0, 1), b2 + hstep, voffB);
            PG8_WAIT_V(6); PG8_BAR; PG8_MMA(1, 1, At, B1); PG8_BAR;
            PG8_LDB(B0, 1, 0); PG8_SCHED; PG8_LDA(At, 1, 0); PG8_STAGE(PG8_SA(0, 1), a2 + hstep, voffA);
            PG8_WAIT_L(8); PG8_BAR; PG8_WAIT_L(0); PG8_MMA(0, 0, At, B0); PG8_BAR; PG8_SCHED;
            PG8_LDB(B1, 1, 1); PG8_STAGE(PG8_SB(1, 0), b3, voffB);
            PG8_BAR; PG8_WAIT_L(0); PG8_MMA(0, 1, At, B1); PG8_BAR;
            PG8_LDA(At, 1, 1); PG8_STAGE(PG8_SA(1, 0), a3, voffA);
            PG8_BAR; PG8_WAIT_L(0); PG8_MMA(1, 0, At, B0); PG8_BAR; PG8_SCHED;
            PG8_STAGE(PG8_SB(1, 1), b3 + hstep, voffB);
            PG8_WAIT_V(6); PG8_BAR; PG8_MMA(1, 1, At, B1); PG8_BAR;
            }
        }
        if constexpr (ALIGN_EPI) { if (wr == 0) PG8_BAR; }
        if constexpr (!Epi::AFTER_DRAIN) { E(acc, cur, wr, wc, fr, fq); S.done(cur); }
        if (!has_next) break;
#pragma unroll
        for (int a = 0; a < 2; ++a)
#pragma unroll
            for (int b = 0; b < 2; ++b)
#pragma unroll
                for (int m = 0; m < 4; ++m)
#pragma unroll
                    for (int n = 0; n < 2; ++n) acc[a][b][m][n] = (f32x4){0.f, 0.f, 0.f, 0.f};
        cur = nxt; cA = nA; cB = nB; ++ui;
        if constexpr (ALIGN_EPI) { if (wr == 1) PG8_BAR; }
    }
    PG8_WAIT_V(0);
    if constexpr (!ALIGN_EPI) { if (wr == 0) PG8_BAR; }
    PG8_BAR;
    if constexpr (Epi::AFTER_DRAIN) { E.fused(acc, cur, wr, wc, fr, fq, lds, wid, lane); S.done(cur); }
#undef PG8_SA
#undef PG8_SB
#undef PG8_STAGE
#undef PG8_LDA
#undef PG8_LDB
#undef PG8_MMA
#undef PG8_WAIT_V
#undef PG8_WAIT_L
#undef PG8_BAR
#undef PG8_SCHED
}
}

#define LAS __attribute__((address_space(3)))
#define DI __device__ __forceinline__
typedef unsigned short bf16_t;
typedef short bf16x8 __attribute__((ext_vector_type(8)));
typedef short s16x4 __attribute__((ext_vector_type(4)));
typedef short v4i16_t __attribute__((ext_vector_type(4)));
typedef float f32x4 __attribute__((ext_vector_type(4)));
typedef float f32x2_t __attribute__((ext_vector_type(2)));
typedef __bf16 bf16x2_t __attribute__((ext_vector_type(2)));
typedef unsigned u32x4 __attribute__((ext_vector_type(4)));
typedef unsigned u32x2 __attribute__((ext_vector_type(2)));

constexpr int NTOK = 65536, DM = 1024, SEQ = 8192;
constexpr size_t MiB = 1u << 20;
constexpr size_t WS_MOD = 0;
constexpr size_t WS_INVF = 256 * 1024;
constexpr size_t WS_SW1 = 512 * 1024;
constexpr size_t WS_W0IN = 1 * MiB, WS_W0OUT = 13 * MiB, WS_W1IN = 17 * MiB, WS_W1OUT = 33 * MiB;
constexpr size_t WS_SSQ = 37 * MiB;
constexpr size_t WS_H = 48 * MiB;
constexpr size_t WS_ACT = 176 * MiB;
constexpr size_t WS_Q0 = WS_ACT, WS_K0 = WS_ACT + 128 * MiB, WS_V0 = WS_ACT + 256 * MiB;
constexpr size_t WS_Q1 = WS_ACT, WS_K1 = WS_ACT + 256 * MiB, WS_V1 = WS_ACT + 512 * MiB;
constexpr size_t WS_END = WS_ACT + 768 * MiB;
constexpr int LDS_BYTES = 147456;
constexpr float EPSF = 1e-6f;

DI unsigned pkbf(float lo, float hi) { f32x2_t v = {lo, hi}; bf16x2_t b = __builtin_convertvector(v, bf16x2_t); return __builtin_bit_cast(unsigned, b); }
DI float bflo(unsigned u) { return __builtin_bit_cast(float, u << 16); }
DI float bfhi(unsigned u) { return __builtin_bit_cast(float, u & 0xffff0000u); }
DI float ex2(float x) { return __builtin_amdgcn_exp2f(x); }
DI f32x4 mfma16(bf16x8 a, bf16x8 b, f32x4 c) { return __builtin_amdgcn_mfma_f32_16x16x32_bf16(a, b, c, 0, 0, 0); }
DI s16x4 tr_read(const LAS unsigned char* p) { return __builtin_bit_cast(s16x4, __builtin_amdgcn_ds_read_tr16_b64_v4i16((LAS v4i16_t*)p)); }
DI bf16x8 cat4(s16x4 lo, s16x4 hi) { return __builtin_shufflevector(lo, hi, 0, 1, 2, 3, 4, 5, 6, 7); }
DI bf16x8 pack8(f32x4 a, f32x4 b) { u32x4 p; p.x = pkbf(a[0], a[1]); p.y = pkbf(a[2], a[3]); p.z = pkbf(b[0], b[1]); p.w = pkbf(b[2], b[3]); return __builtin_bit_cast(bf16x8, p); }
DI float silu_f(float g) { return g * __builtin_amdgcn_rcpf(1.f + ex2(-1.4426950408889634f * g)); }
#define LDS_BARRIER() do { asm volatile("s_waitcnt lgkmcnt(0)" ::: "memory"); __builtin_amdgcn_s_barrier(); asm volatile("" ::: "memory"); } while (0)
DI float wave_sum(float v) {
#pragma unroll
    for (int o = 1; o < 64; o <<= 1) v += __shfl_xor(v, o);
    return v;
}
DI float dpp_f(float v, const int ctrl_sel) {
    const int x = __builtin_bit_cast(int, v); int r;
    if (ctrl_sel == 0) r = __builtin_amdgcn_update_dpp(x, x, 0xB1, 0xF, 0xF, false);
    else if (ctrl_sel == 1) r = __builtin_amdgcn_update_dpp(x, x, 0x4E, 0xF, 0xF, false);
    else if (ctrl_sel == 2) r = __builtin_amdgcn_update_dpp(x, x, 0x141, 0xF, 0xF, false);
    else r = __builtin_amdgcn_update_dpp(x, x, 0x140, 0xF, 0xF, false);
    return __builtin_bit_cast(float, r); }
DI float row16_sum(float v) { v += dpp_f(v, 0); v += dpp_f(v, 1); v += dpp_f(v, 2); v += dpp_f(v, 3); return v; }
DI float ssq8(u32x4 v) { float s = 0.f;
#pragma unroll
    for (int e = 0; e < 4; ++e) { const float a = bflo(v[e]), b = bfhi(v[e]); s += a * a + b * b; }
    return s; }

typedef const f32x4 (&AccRef)[2][2][4][2];
constexpr float INV2PI_HI = 0.15915493667125702f, INV2PI_LO = 6.4206382432985265e-09f;

struct EpiA0 {
    static constexpr bool PERM = true, AFTER_DRAIN = false;
    bf16_t *Q, *K, *V; const int* pos; const float* invf;
    DI void operator()(AccRef acc, const pg8::Unit& u, int wr, int wc, int fr, int fq) const {
        const int row0 = u.pm * 256 + wr * 64 + fr;
        if (u.pn < 8) {
            bf16_t* base = (u.pn < 4 ? Q : K) + (u.pn & 3) * 256;
            const float sc = u.pn < 4 ? 1.f : 0.0625f;
            const int cl = wc * 32 + 8 * fq;
            const f32x4 f0 = *(const f32x4*)(invf + cl), f1 = *(const f32x4*)(invf + cl + 4);
#pragma unroll
            for (int ai = 0; ai < 2; ++ai)
#pragma unroll
                for (int m = 0; m < 4; ++m) {
                    const int row = row0 + ai * 128 + m * 16;
                    const float p = (float)pos[row];
                    float o1[8], o2[8];
#pragma unroll
                    for (int n = 0; n < 2; ++n)
#pragma unroll
                        for (int i = 0; i < 4; ++i) {
                            const float ang = p * (n == 0 ? f0[i] : f1[i]);
                            const float hi = ang * INV2PI_HI;
                            float lo = __builtin_fmaf(ang, INV2PI_HI, -hi); lo = __builtin_fmaf(ang, INV2PI_LO, lo);
                            const float r = __builtin_amdgcn_fractf(hi) + lo;
                            const float s = __builtin_amdgcn_sinf(r), c = __builtin_amdgcn_cosf(r);
                            const float t1 = acc[ai][0][m][n][i], t2 = acc[ai][1][m][n][i];
                            o1[4 * n + i] = (t1 * c - t2 * s) * sc; o2[4 * n + i] = (t1 * s + t2 * c) * sc;
                        }
                    bf16_t* rp = base + (size_t)row * 1024 + cl;
                    u32x4 w1, w2;
                    w1.x = pkbf(o1[0], o1[1]); w1.y = pkbf(o1[2], o1[3]); w1.z = pkbf(o1[4], o1[5]); w1.w = pkbf(o1[6], o1[7]);
                    w2.x = pkbf(o2[0], o2[1]); w2.y = pkbf(o2[2], o2[3]); w2.z = pkbf(o2[4], o2[5]); w2.w = pkbf(o2[6], o2[7]);
                    *(u32x4*)rp = w1; *(u32x4*)(rp + 128) = w2;
                }
        } else {
            const int col0 = (u.pn - 8) * 256 + wc * 32 + 8 * fq;
#pragma unroll
            for (int ai = 0; ai < 2; ++ai)
#pragma unroll
                for (int m = 0; m < 4; ++m) {
                    bf16_t* rp = V + (size_t)(row0 + ai * 128 + m * 16) * 2048 + col0;
#pragma unroll
                    for (int bj = 0; bj < 2; ++bj) { const f32x4 v0 = acc[ai][bj][m][0], v1 = acc[ai][bj][m][1];
                        u32x4 w; w.x = pkbf(v0[0], v0[1]); w.y = pkbf(v0[2], v0[3]); w.z = pkbf(v1[0], v1[1]); w.w = pkbf(v1[2], v1[3]);
                        *(u32x4*)(rp + bj * 128) = w; }
                }
        }
    }
};

DI float rstd16(const float* ssq1, int row) {
    const f32x4 a = *(const f32x4*)(ssq1 + (size_t)row * 4);
    return __builtin_amdgcn_rsqf(((a[0] + a[1]) + (a[2] + a[3])) * (1.f / 1024.f) + EPSF);
}
struct EpiA1 {
    static constexpr bool PERM = true, AFTER_DRAIN = false;
    bf16_t* Q; const float* ssq1; const float* sw;
    DI void operator()(AccRef acc, const pg8::Unit& u, int wr, int wc, int fr, int fq) const {
        const int row0 = u.pm * 256 + wr * 64 + fr;
        bf16_t* base = Q + (size_t)(u.pn >> 3) * ((size_t)NTOK * 2048);
        const int col0 = (u.pn & 7) * 256 + wc * 32 + 8 * fq;
        const float* swp = sw + (size_t)(u.pm >> 5) * 8192 + u.pn * 256 + wc * 32 + 8 * fq;
        f32x4 sv[2][2];
#pragma unroll
        for (int bj = 0; bj < 2; ++bj) { sv[bj][0] = *(const f32x4*)(swp + bj * 128); sv[bj][1] = *(const f32x4*)(swp + bj * 128 + 4); }
#pragma unroll
        for (int ai = 0; ai < 2; ++ai)
#pragma unroll
            for (int m = 0; m < 4; ++m) {
                const int row = row0 + ai * 128 + m * 16;
                const float rs = rstd16(ssq1, row);
                bf16_t* rp = base + (size_t)row * 2048 + col0;
#pragma unroll
                for (int bj = 0; bj < 2; ++bj) { const f32x4 v0 = acc[ai][bj][m][0] * rs + sv[bj][0], v1 = acc[ai][bj][m][1] * rs + sv[bj][1];
                    u32x4 w; w.x = pkbf(v0[0], v0[1]); w.y = pkbf(v0[2], v0[3]); w.z = pkbf(v1[0], v1[1]); w.w = pkbf(v1[2], v1[3]);
                    *(u32x4*)(rp + bj * 128) = w; }
            }
    }
};

template <int L> struct EpiG {
    static constexpr bool PERM = true, AFTER_DRAIN = false;
    bf16_t* O; const float* ssq; const float* gn; const float* sw;
    DI void operator()(AccRef acc, const pg8::Unit& u, int wr, int wc, int fr, int fq) const {
        const int row0 = u.pm * 256 + wr * 64 + fr;
        const int col0 = u.pn * 256 + wc * 32 + 8 * fq, head = u.pn >> 1;
        float gnv[2][8];
#pragma unroll
        for (int bj = 0; bj < 2; ++bj)
#pragma unroll
            for (int e = 0; e < 8; ++e) gnv[bj][e] = (L == 0) ? gn[col0 + bj * 128 + e] : 1.f;
#pragma unroll
        for (int ai = 0; ai < 2; ++ai)
#pragma unroll
            for (int m = 0; m < 4; ++m) {
                const int row = row0 + ai * 128 + m * 16;
                float rstd = 1.f, rs1 = 1.f;
                if (L == 1) rs1 = rstd16(ssq, row);
                if (L == 0) { const float* sp = ssq + ((size_t)row * 4 + head) * 8; const f32x4 s0 = *(const f32x4*)sp, s1 = *(const f32x4*)(sp + 4);
                    const float tot = ((s0[0] + s0[1]) + (s0[2] + s0[3])) + ((s1[0] + s1[1]) + (s1[2] + s1[3]));
                    rstd = __builtin_amdgcn_rsqf(tot * (1.f / 512.f) + EPSF); }
                bf16_t* rp = O + (size_t)row * 2048 + col0;
#pragma unroll
                for (int bj = 0; bj < 2; ++bj) {
                    const u32x4 ov = *(const u32x4*)(rp + bj * 128);
                    f32x4 g0 = acc[ai][bj][m][0], g1 = acc[ai][bj][m][1];
                    if (L == 1) { const float* swp = sw + (size_t)(u.pm >> 5) * 8192 + 6144 + col0 + bj * 128; g0 = g0 * rs1 + *(const f32x4*)swp; g1 = g1 * rs1 + *(const f32x4*)(swp + 4); }
                    float r[8];
#pragma unroll
                    for (int e = 0; e < 4; ++e) { const float ga = (e < 2 ? g0[2 * e] : g1[2 * e - 4]), gb = (e < 2 ? g0[2 * e + 1] : g1[2 * e - 3]);
                        r[2 * e] = bflo(ov[e]) * silu_f(ga) * (rstd * gnv[bj][2 * e]); r[2 * e + 1] = bfhi(ov[e]) * silu_f(gb) * (rstd * gnv[bj][2 * e + 1]); }
                    u32x4 w; w.x = pkbf(r[0], r[1]); w.y = pkbf(r[2], r[3]); w.z = pkbf(r[4], r[5]); w.w = pkbf(r[6], r[7]);
                    *(u32x4*)(rp + bj * 128) = w;
                }
            }
    }
};

struct EpiOut {
    static constexpr bool PERM = true, AFTER_DRAIN = false;
    const float* xin; float* xout; const float* gate;
    DI void operator()(AccRef acc, const pg8::Unit& u, int wr, int wc, int fr, int fq) const {
        const int row0 = u.pm * 256 + wr * 64 + fr;
        const int col0 = u.pn * 256 + wc * 32 + 8 * fq;
        const float* gp = gate + (size_t)(u.pm >> 5) * 3072 + col0;
        f32x4 gv[2][2];
#pragma unroll
        for (int bj = 0; bj < 2; ++bj) { gv[bj][0] = *(const f32x4*)(gp + bj * 128); gv[bj][1] = *(const f32x4*)(gp + bj * 128 + 4); }
#pragma unroll
        for (int ai = 0; ai < 2; ++ai)
#pragma unroll
            for (int m = 0; m < 4; ++m) {
                const size_t off = (size_t)(row0 + ai * 128 + m * 16) * 1024 + col0;
#pragma unroll
                for (int bj = 0; bj < 2; ++bj) {
                    const f32x4 x0 = *(const f32x4*)(xin + off + bj * 128), x1 = *(const f32x4*)(xin + off + bj * 128 + 4);
                    *(f32x4*)(xout + off + bj * 128) = x0 + gv[bj][0] * acc[ai][bj][m][0];
                    *(f32x4*)(xout + off + bj * 128 + 4) = x1 + gv[bj][1] * acc[ai][bj][m][1];
                }
            }
    }
};

struct EpiOutLN {
    static constexpr bool PERM = true, AFTER_DRAIN = false;
    const float* xin; float* xout; const float* gate; bf16_t* H; const float* g1; const float* scale1; float* ssq1; LAS float* red;
    DI void operator()(AccRef acc, const pg8::Unit& u, int wr, int wc, int fr, int fq) const {
        const int row0 = u.pm * 256 + wr * 64 + fr;
        const int col0 = u.pn * 256 + wc * 32 + 8 * fq;
        const float* gp = gate + (size_t)(u.pm >> 5) * 3072 + col0;
        const float* sp = scale1 + (size_t)(u.pm >> 5) * 3072 + col0;
        float sq[8];
#pragma unroll
        for (int i = 0; i < 8; ++i) sq[i] = 0.f;
#pragma unroll
        for (int bj = 0; bj < 2; ++bj) {
            const f32x4 gv0 = *(const f32x4*)(gp + bj * 128), gv1 = *(const f32x4*)(gp + bj * 128 + 4);
            const f32x4 av0 = *(const f32x4*)(g1 + col0 + bj * 128) * (*(const f32x4*)(sp + bj * 128) + 1.f), av1 = *(const f32x4*)(g1 + col0 + bj * 128 + 4) * (*(const f32x4*)(sp + bj * 128 + 4) + 1.f);
#pragma unroll
            for (int ai = 0; ai < 2; ++ai)
#pragma unroll
                for (int m = 0; m < 4; ++m) {
                    const size_t off = (size_t)(row0 + ai * 128 + m * 16) * 1024 + col0 + bj * 128;
                    const f32x4 x0 = *(const f32x4*)(xin + off) + gv0 * acc[ai][bj][m][0], x1 = *(const f32x4*)(xin + off + 4) + gv1 * acc[ai][bj][m][1];
                    *(f32x4*)(xout + off) = x0; *(f32x4*)(xout + off + 4) = x1;
                    sq[ai * 4 + m] += ((x0[0] * x0[0] + x0[1] * x0[1]) + (x0[2] * x0[2] + x0[3] * x0[3])) + ((x1[0] * x1[0] + x1[1] * x1[1]) + (x1[2] * x1[2] + x1[3] * x1[3]));
                    const f32x4 h0 = x0 * av0, h1 = x1 * av1;
                    u32x4 w; w.x = pkbf(h0[0], h0[1]); w.y = pkbf(h0[2], h0[3]); w.z = pkbf(h1[0], h1[1]); w.w = pkbf(h1[2], h1[3]);
                    *(u32x4*)(H + off) = w;
                }
        }
#pragma unroll
        for (int i = 0; i < 8; ++i) {
            float t = sq[i]; t += __shfl_xor(t, 16); t += __shfl_xor(t, 32);
            if (fq == 0) red[wc * 256 + (i >> 2) * 128 + wr * 64 + (i & 3) * 16 + fr] = t;
        }
        asm volatile("s_waitcnt lgkmcnt(0)" ::: "memory"); __builtin_amdgcn_s_barrier(); asm volatile("" ::: "memory");
        { const int tl = threadIdx.x; if (tl < 256) ssq1[(size_t)(u.pm * 256 + tl) * 4 + u.pn] = (red[tl] + red[256 + tl]) + (red[512 + tl] + red[768 + tl]); }
        asm volatile("s_waitcnt lgkmcnt(0)" ::: "memory");
    }
};

DI unsigned f2bf(float f) { unsigned u = __builtin_bit_cast(unsigned, f); return (u + 0x7fffu + ((u >> 16) & 1u)) >> 16; }
DI unsigned pk2(float lo, float hi) { return f2bf(lo) | (f2bf(hi) << 16); }
DI void p0_transpose_item(const float* W, int K, int N, bf16_t* WT, LAS float* scr, int item, int lane) {
    const int nblk = N / 32, kb = item / nblk, nb = item % nblk, k0 = 64 * kb, n0 = 32 * nb;
#pragma unroll 8
    for (int i = 0; i < 32; ++i) { const int kk = 2 * i + (lane >> 5); scr[kk * 33 + (lane & 31)] = W[(size_t)(k0 + kk) * N + n0 + (lane & 31)]; }
    asm volatile("s_waitcnt lgkmcnt(0)" ::: "memory");
    const int c = lane & 7;
#pragma unroll
    for (int j = 0; j < 4; ++j) { const int n = (lane >> 3) + 8 * j; const LAS float* s = scr + (8 * c) * 33 + n;
        u32x4 o; o.x = pk2(s[0 * 33], s[1 * 33]); o.y = pk2(s[2 * 33], s[3 * 33]); o.z = pk2(s[4 * 33], s[5 * 33]); o.w = pk2(s[6 * 33], s[7 * 33]);
        *(u32x4*)(WT + (size_t)(n0 + n) * K + k0 + 8 * c) = o; }
    asm volatile("s_waitcnt lgkmcnt(0)" ::: "memory");
}

DI void p0_phase(LAS unsigned char* lds, const float* cvec, const float* ada_w, const float* ada_b, const float* w0in, const float* w0out, const float* w1in, const float* w1out,
                 unsigned char* ws, int bid, int G) {
    const int tid = threadIdx.x, lane = tid & 63, w = __builtin_amdgcn_readfirstlane(tid >> 6);
    float* mod = (float*)(ws + WS_MOD);
    if (bid == G - 1 && tid < 128) { float* invf = (float*)(ws + WS_INVF); invf[tid] = 1.0f / powf(10000.0f, (float)(2 * tid) / 256.0f); }
    LAS float* cond = (LAS float*)lds;
    LAS float* red = (LAS float*)(lds + 32768);
    if (bid < 96) {
        for (int i = tid; i < 8192; i += 512) { const float v = cvec[i]; cond[i] = v / (1.f + expf(-v)); }
        __syncthreads();
    }
    for (int mi = bid; mi < 96; mi += G) {
        const int n0 = mi * 64, layer = n0 / 3072, nn = n0 % 3072 + lane;
        const float* wp = ada_w + (size_t)layer * 1024 * 3072 + nn;
        float acc[8];
#pragma unroll
        for (int b = 0; b < 8; ++b) acc[b] = 0.f;
#pragma unroll 8
        for (int kk = 0; kk < 128; ++kk) { const int k = w * 128 + kk; const float wv = wp[(size_t)k * 3072];
#pragma unroll
            for (int b = 0; b < 8; ++b) acc[b] += cond[b * 1024 + k] * wv; }
#pragma unroll
        for (int b = 0; b < 8; ++b) red[(w * 8 + b) * 64 + lane] = acc[b];
        __syncthreads();
        { const int b = tid >> 6; float s = 0.f;
#pragma unroll
          for (int ww = 0; ww < 8; ++ww) s += red[(ww * 8 + b) * 64 + lane];
          mod[((size_t)layer * 8 + b) * 3072 + nn] = s + ada_b[layer * 3072 + nn]; }
        __syncthreads();
    }
    __syncthreads();
    LAS float* scr = (LAS float*)(lds + 65536 + w * 8704);
    const int gw = bid * 8 + w, NGW = G * 8;
    constexpr int I0 = (1024 / 64) * (6144 / 32), I1 = (2048 / 64) * (1024 / 32), I2 = (1024 / 64) * (8192 / 32), I3 = I1;
    for (int it = gw; it < I0 + I1 + I2 + I3; it += NGW) {
        int r = it;
        if (r < I0) { p0_transpose_item(w0in, 1024, 6144, (bf16_t*)(ws + WS_W0IN), scr, r, lane); continue; } r -= I0;
        if (r < I1) { p0_transpose_item(w0out, 2048, 1024, (bf16_t*)(ws + WS_W0OUT), scr, r, lane); continue; } r -= I1;
        if (r < I2) { p0_transpose_item(w1in, 1024, 8192, (bf16_t*)(ws + WS_W1IN), scr, r, lane); continue; } r -= I2;
        p0_transpose_item(w1out, 2048, 1024, (bf16_t*)(ws + WS_W1OUT), scr, r, lane);
    }
}

DI void sw_items(LAS unsigned char* lds, const float* modl, const float* W, int N, float* sw, int bid, int G) {
    const int tid = threadIdx.x, lane = tid & 63, w = __builtin_amdgcn_readfirstlane(tid >> 6);
    LAS float* vec = (LAS float*)lds;
    LAS float* red = (LAS float*)(lds + 32768);
    const int nitems = N / 64;
    if (bid < nitems) {
        for (int i = tid; i < 8192; i += 512) vec[i] = modl[(size_t)(i >> 10) * 3072 + (i & 1023)];
        __syncthreads();
    }
    for (int mi = bid; mi < nitems; mi += G) {
        const int n = mi * 64 + lane;
        const float* wp = W + n;
        float acc[8];
#pragma unroll
        for (int b = 0; b < 8; ++b) acc[b] = 0.f;
#pragma unroll 8
        for (int kk = 0; kk < 128; ++kk) { const int k = w * 128 + kk; const float wv = wp[(size_t)k * N];
#pragma unroll
            for (int b = 0; b < 8; ++b) acc[b] += vec[b * 1024 + k] * wv; }
#pragma unroll
        for (int b = 0; b < 8; ++b) red[(w * 8 + b) * 64 + lane] = acc[b];
        __syncthreads();
        { const int b = tid >> 6; float sm = 0.f;
#pragma unroll
          for (int ww = 0; ww < 8; ++ww) sm += red[(ww * 8 + b) * 64 + lane];
          sw[(size_t)b * N + n] = sm; }
        __syncthreads();
    }
    __syncthreads();
}

DI void ln_phase(const float* xin, bf16_t* h, const float* ng, const float* modl, int gw, int NGW, int lane) {
    for (int m = gw; m < NTOK; m += NGW) {
        const int b = m >> 13;
        const float* xr = xin + (size_t)m * 1024;
        const float* sh = modl + (size_t)b * 3072; const float* scl = sh + 1024;
        f32x4 v[4];
        v[0] = *(const f32x4*)(xr + 8 * lane); v[1] = *(const f32x4*)(xr + 8 * lane + 4); v[2] = *(const f32x4*)(xr + 512 + 8 * lane); v[3] = *(const f32x4*)(xr + 512 + 8 * lane + 4);
        float ss = 0.f;
#pragma unroll
        for (int i = 0; i < 4; ++i) ss += (v[i][0] * v[i][0] + v[i][1] * v[i][1]) + (v[i][2] * v[i][2] + v[i][3] * v[i][3]);
        ss = wave_sum(ss);
        const float rstd = 1.0f / sqrtf(ss * (1.f / 1024.f) + EPSF);
        float o[16];
#pragma unroll
        for (int i = 0; i < 4; ++i) { const int c = (i >> 1) * 512 + 8 * lane + (i & 1) * 4;
            const f32x4 g = *(const f32x4*)(ng + c), s1 = *(const f32x4*)(scl + c), s0 = *(const f32x4*)(sh + c);
#pragma unroll
            for (int e = 0; e < 4; ++e) o[4 * i + e] = v[i][e] * rstd * g[e] * (1.f + s1[e]) + s0[e]; }
        u32x4 w0, w1;
        w0.x = pkbf(o[0], o[1]); w0.y = pkbf(o[2], o[3]); w0.z = pkbf(o[4], o[5]); w0.w = pkbf(o[6], o[7]);
        w1.x = pkbf(o[8], o[9]); w1.y = pkbf(o[10], o[11]); w1.z = pkbf(o[12], o[13]); w1.w = pkbf(o[14], o[15]);
        *(u32x4*)(h + (size_t)m * 1024 + 8 * lane) = w0; *(u32x4*)(h + (size_t)m * 1024 + 512 + 8 * lane) = w1;
    }
}

constexpr int R_QSTR = 528, R_KSTR = 544, R_VSTR = 160, R_PSTR = 144;
constexpr int R_QL = 0, R_KL = R_QL + 64 * R_QSTR, R_VL = R_KL + 64 * R_KSTR, R_PL = R_VL + 64 * R_VSTR, R_XL = R_PL + 64 * R_PSTR, R_SL = R_XL + 16384, R_END = R_SL + 4096;
static_assert(R_END <= LDS_BYTES, "retention LDS");

template <int KH> DI void ret_rd16(s16x4 (&qb)[16], unsigned own_addr, unsigned oth_addr) {
    asm volatile("ds_read_b64 %0, %16 offset:%18\n\t"
                        "ds_read_b64 %1, %16 offset:%19\n\t"
                        "ds_read_b64 %2, %17 offset:%18\n\t"
                        "ds_read_b64 %3, %17 offset:%19\n\t"
                        "ds_read_b64 %4, %16 offset:%20\n\t"
                        "ds_read_b64 %5, %16 offset:%21\n\t"
                        "ds_read_b64 %6, %17 offset:%20\n\t"
                        "ds_read_b64 %7, %17 offset:%21\n\t"
                        "ds_read_b64 %8, %16 offset:%22\n\t"
                        "ds_read_b64 %9, %16 offset:%23\n\t"
                        "ds_read_b64 %10, %17 offset:%22\n\t"
                        "ds_read_b64 %11, %17 offset:%23\n\t"
                        "ds_read_b64 %12, %16 offset:%24\n\t"
                        "ds_read_b64 %13, %16 offset:%25\n\t"
                        "ds_read_b64 %14, %17 offset:%24\n\t"
                        "ds_read_b64 %15, %17 offset:%25\n\t"
                        "s_waitcnt lgkmcnt(0)"
                 : "=&v"(qb[0]), "=&v"(qb[1]), "=&v"(qb[2]), "=&v"(qb[3]), "=&v"(qb[4]), "=&v"(qb[5]), "=&v"(qb[6]), "=&v"(qb[7]), "=&v"(qb[8]), "=&v"(qb[9]), "=&v"(qb[10]), "=&v"(qb[11]), "=&v"(qb[12]), "=&v"(qb[13]), "=&v"(qb[14]), "=&v"(qb[15])
                 : "v"(own_addr), "v"(oth_addr), "n"(0 * 16 * R_QSTR + (2 * KH + 0) * 64 + 0 * 32), "n"(0 * 16 * R_QSTR + (2 * KH + 0) * 64 + 1 * 32), "n"(1 * 16 * R_QSTR + (2 * KH + 0) * 64 + 0 * 32), "n"(1 * 16 * R_QSTR + (2 * KH + 0) * 64 + 1 * 32), "n"(0 * 16 * R_QSTR + (2 * KH + 1) * 64 + 0 * 32), "n"(0 * 16 * R_QSTR + (2 * KH + 1) * 64 + 1 * 32), "n"(1 * 16 * R_QSTR + (2 * KH + 1) * 64 + 0 * 32), "n"(1 * 16 * R_QSTR + (2 * KH + 1) * 64 + 1 * 32)
                 : "memory");
}

template <int SH> DI void ret_phase(LAS unsigned char* lds, const bf16_t* Q0, const bf16_t* K0, bf16_t* V0, float* ssq, int vcu, int G, int magic) {
    const int tid = threadIdx.x, lane = tid & 63, w = __builtin_amdgcn_readfirstlane(tid >> 6), fr = lane & 15, fq = lane >> 4;
    const int et = w & 3, dh = w >> 2;
    for (int it = vcu; it < 256; it += G) {
        const int bh = it >> 3, dvt = it & 7, b = bh >> 2, h = bh & 3;
        const float lg2 = log2f(1.0f - exp2f(-5.0f - (float)h));
        const float cd = exp2f(lg2 * 64.f);
        float kd[2][8];
#pragma unroll
        for (int s = 0; s < 2; ++s)
#pragma unroll
            for (int jj = 0; jj < 8; ++jj) kd[s][jj] = exp2f(lg2 * (float)(63 - (32 * s + 16 * (jj >> 2) + 4 * fq + (jj & 3))));
        const int ct_own = 2 * dh, ct_oth = 2 * (1 - dh);
        float qd[2];
#pragma unroll
        for (int i = 0; i < 2; ++i) qd[i] = exp2f(lg2 * (float)(16 * (ct_own + i) + fr + 1));
        f32x4 st[8];
#pragma unroll
        for (int t = 0; t < 8; ++t) st[t] = (f32x4){0.f, 0.f, 0.f, 0.f};
        const size_t tok0 = (size_t)b * SEQ;
        u32x4 qr[4], kr[4], vr;
#define R_ISSUE(j) do { _Pragma("unroll") for (int i_ = 0; i_ < 4; ++i_) { const int ch_ = tid + 512 * i_; const size_t g_ = (tok0 + (size_t)(j) * 64 + (ch_ >> 5)) * 1024 + h * 256 + (ch_ & 31) * 8; \
            qr[i_] = *(const u32x4*)(Q0 + g_); kr[i_] = *(const u32x4*)(K0 + g_); } \
            vr = *(const u32x4*)(V0 + (tok0 + (size_t)(j) * 64 + (tid >> 3)) * 2048 + h * 512 + dvt * 64 + (tid & 7) * 8); } while (0)
#define R_WRITE() do { _Pragma("unroll") for (int i_ = 0; i_ < 4; ++i_) { const int ch_ = tid + 512 * i_; \
            *(LAS u32x4*)(lds + R_QL + (ch_ >> 5) * R_QSTR + (ch_ & 31) * 16) = qr[i_]; *(LAS u32x4*)(lds + R_KL + (ch_ >> 5) * R_KSTR + (ch_ & 31) * 16) = kr[i_]; } \
            *(LAS u32x4*)(lds + R_VL + (tid >> 3) * R_VSTR + (tid & 7) * 16) = vr; } while (0)
        R_ISSUE(0); R_WRITE(); LDS_BARRIER();
        for (int j = 0; j < 128; ++j) {
            if (SH != 1 && j + 1 < 128) R_ISSUE(j + 1);
            if (SH == 0 && j > 0 && tid < 64) { const LAS float* sl = (const LAS float*)(lds + R_SL) + tid; float sa = 0.f;
#pragma unroll
                for (int u = 0; u < 16; ++u) sa += sl[u * 64];
                ssq[((tok0 + (size_t)(j - 1) * 64 + tid) * 4 + h) * 8 + dvt] = sa; }
            {
                const int kt = w & 3, ctp = w >> 2;
                f32x4 sc0 = (f32x4){0.f, 0.f, 0.f, 0.f}, sc1 = sc0;
                const LAS unsigned char* kp = lds + R_KL + (16 * kt + fr) * R_KSTR + fq * 16;
                const LAS unsigned char* qp = lds + R_QL + (32 * ctp + fr) * R_QSTR + fq * 16;
#pragma unroll
                for (int ks = 0; ks < 8; ++ks) {
                    const bf16x8 kf = *(const LAS bf16x8*)(kp + ks * 64), q0 = *(const LAS bf16x8*)(qp + ks * 64), q1 = *(const LAS bf16x8*)(qp + 16 * R_QSTR + ks * 64);
                    sc0 = mfma16(kf, q0, sc0); sc1 = mfma16(kf, q1, sc1);
                }
                const int c0 = 32 * ctp + fr, kbase = 16 * kt + 4 * fq;
                float p0[4], p1[4];
#pragma unroll
                for (int r = 0; r < 4; ++r) { const int d0 = c0 - (kbase + r), d1 = d0 + 16;
                    p0[r] = sc0[r] * ex2(lg2 * (float)(d0 < 0 ? -d0 : d0)); p1[r] = sc1[r] * ex2(lg2 * (float)(d1 < 0 ? -d1 : d1)); }
                u32x2 w0, w1; w0.x = pkbf(p0[0], p0[1]); w0.y = pkbf(p0[2], p0[3]); w1.x = pkbf(p1[0], p1[1]); w1.y = pkbf(p1[2], p1[3]);
                *(LAS u32x2*)(lds + R_PL + c0 * R_PSTR + kbase * 2) = w0; *(LAS u32x2*)(lds + R_PL + (c0 + 16) * R_PSTR + kbase * 2) = w1;
            }
            f32x4 own[2], oth[2];
#pragma unroll
            for (int i = 0; i < 2; ++i) { own[i] = (f32x4){0.f, 0.f, 0.f, 0.f}; oth[i] = own[i]; }
            {
                const unsigned qo_a = (unsigned)(size_t)(lds + R_QL + (16 * ct_own + fr) * R_QSTR + (128 * dh + 4 * fq) * 2);
                const unsigned qt_a = (unsigned)(size_t)(lds + R_QL + (16 * ct_oth + fr) * R_QSTR + (128 * dh + 4 * fq) * 2);
                s16x4 qb[16];
                ret_rd16<0>(qb, qo_a, qt_a);
#pragma unroll
                for (int kk = 0; kk < 2; ++kk) {
                    const bf16x8 a = pack8(st[2 * kk], st[2 * kk + 1]);
#pragma unroll
                    for (int i = 0; i < 2; ++i) { own[i] = mfma16(a, cat4(qb[kk * 8 + i * 4], qb[kk * 8 + i * 4 + 1]), own[i]); oth[i] = mfma16(a, cat4(qb[kk * 8 + i * 4 + 2], qb[kk * 8 + i * 4 + 3]), oth[i]); }
                }
                ret_rd16<1>(qb, qo_a, qt_a);
#pragma unroll
                for (int kk = 0; kk < 2; ++kk) {
                    const bf16x8 a = pack8(st[4 + 2 * kk], st[4 + 2 * kk + 1]);
#pragma unroll
                    for (int i = 0; i < 2; ++i) { own[i] = mfma16(a, cat4(qb[kk * 8 + i * 4], qb[kk * 8 + i * 4 + 1]), own[i]); oth[i] = mfma16(a, cat4(qb[kk * 8 + i * 4 + 2], qb[kk * 8 + i * 4 + 3]), oth[i]); }
                }
#pragma unroll
                for (int i = 0; i < 2; ++i) *(LAS f32x4*)(lds + R_XL + ((w * 2 + i) * 64 + lane) * 16) = oth[i];
            }
            bf16x8 vf[2];
#pragma unroll
            for (int s = 0; s < 2; ++s) {
                const LAS unsigned char* va = lds + R_VL + (32 * s + 4 * fq + (fr >> 2)) * R_VSTR + (16 * et + 4 * (fr & 3)) * 2;
                vf[s] = cat4(tr_read(va), tr_read(va + 16 * R_VSTR));
            }
#pragma unroll
            for (int t = 0; t < 8; ++t) st[t] = st[t] * cd;
#pragma unroll
            for (int s = 0; s < 2; ++s) {
                const u32x4 vu = __builtin_bit_cast(u32x4, vf[s]); u32x4 vsu;
#pragma unroll
                for (int e = 0; e < 4; ++e) vsu[e] = pkbf(bflo(vu[e]) * kd[s][2 * e], bfhi(vu[e]) * kd[s][2 * e + 1]);
                const bf16x8 vs = __builtin_bit_cast(bf16x8, vsu);
                const LAS unsigned char* ka = lds + R_KL + (32 * s + 4 * fq + (fr >> 2)) * R_KSTR + (128 * dh + 4 * (fr & 3)) * 2;
#pragma unroll
                for (int t = 0; t < 8; ++t) st[t] = mfma16(cat4(tr_read(ka + t * 32), tr_read(ka + t * 32 + 16 * R_KSTR)), vs, st[t]);
            }
            LDS_BARRIER();
            {
                const int pw = et + 4 * (1 - dh);
#pragma unroll
                for (int i = 0; i < 2; ++i) { const f32x4 o2 = *(const LAS f32x4*)(lds + R_XL + ((pw * 2 + i) * 64 + lane) * 16); own[i] = (own[i] + o2) * qd[i]; }
            }
#pragma unroll
            for (int s = 0; s < 2; ++s)
#pragma unroll
                for (int i = 0; i < 2; ++i) { const LAS unsigned char* pa = lds + R_PL + (16 * (ct_own + i) + fr) * R_PSTR + (32 * s + 4 * fq) * 2;
                    own[i] = mfma16(vf[s], cat4(*(const LAS s16x4*)pa, *(const LAS s16x4*)(pa + 32)), own[i]); }
            if (j + 1 < 128) R_WRITE();
#pragma unroll
            for (int i = 0; i < 2; ++i) {
                const int c = 16 * (ct_own + i) + fr;
                u32x2 ow; ow.x = pkbf(own[i][0], own[i][1]); ow.y = pkbf(own[i][2], own[i][3]);
                const float sq = (own[i][0] * own[i][0] + own[i][1] * own[i][1]) + (own[i][2] * own[i][2] + own[i][3] * own[i][3]);
                if (SH == 0 || sq == (float)magic) *(u32x2*)(V0 + (tok0 + (size_t)j * 64 + c) * 2048 + h * 512 + dvt * 64 + 16 * et + 4 * fq) = ow;
                *(LAS float*)(lds + R_SL + ((et * 4 + fq) * 64 + c) * 4) = sq;
            }
            LDS_BARRIER();
        }
        if (SH == 0 && tid < 64) { const LAS float* sl = (const LAS float*)(lds + R_SL) + tid; float sa = 0.f;
#pragma unroll
            for (int u = 0; u < 16; ++u) sa += sl[u * 64];
            ssq[((tok0 + (size_t)127 * 64 + tid) * 4 + h) * 8 + dvt] = sa; }
        LDS_BARRIER();
#undef R_ISSUE
#undef R_WRITE
    }
}

constexpr int A_KSTR = 288, A_VSTR = 288, A_KT = 64 * A_KSTR, A_VT = 64 * A_VSTR, A_BUF = A_KT + A_VT, A_TAB = 2 * A_BUF, A_END = A_TAB + 1280;
static_assert(A_END <= LDS_BYTES, "attention LDS");
constexpr float LOG2E = 1.4426950408889634f;

template <int SH> DI void att_phase(LAS unsigned char* lds, bf16_t* Q1, const bf16_t* K1, const bf16_t* V1, const float* qg, const float* kg, const float* rel, int vcu, int G, int magic) {
    const int tid = threadIdx.x, lane = tid & 63, w = __builtin_amdgcn_readfirstlane(tid >> 6), fr = lane & 15, fq = lane >> 4;
    const int lrow = tid >> 4, lcc = tid & 15;
    float kgv[8];
#pragma unroll
    for (int e = 0; e < 8; ++e) kgv[e] = kg[lcc * 8 + e];
    LAS float* tab = (LAS float*)(lds + A_TAB);
    float gmx;
    { float a = fmaxf(fabsf(qg[lane]), fabsf(qg[lane + 64])), c = fmaxf(fabsf(kg[lane]), fabsf(kg[lane + 64]));
#pragma unroll
      for (int o = 1; o < 64; o <<= 1) { a = fmaxf(a, __shfl_xor(a, o)); c = fmaxf(c, __shfl_xor(c, o)); }
      gmx = 11.313708498984761f * a * c * LOG2E; }
    for (int it = vcu; it < 4096; it += G) {
        const int b = it >> 9, h = (it >> 5) & 15, jg = it & 31;
        const int jw = 4 * jg + (w >> 1), qoff = (w & 1) * 32;
        const size_t qrow0 = (size_t)b * SEQ + (size_t)jw * 64 + qoff;
        const int rot = (8 * jg) % 12, nst = 12;
#define A_KC(t) (4 * jg - 8 + (((t) + rot) % 12))
        u32x4 kr0, kr1, vr0, vr1;
#define A_ISSUE(kc) do { const int kc_ = (kc) < 0 ? 0 : (kc); const size_t g_ = ((size_t)b * SEQ + (size_t)kc_ * 64 + lrow) * 2048 + h * 128 + lcc * 8; \
            kr0 = *(const u32x4*)(K1 + g_); kr1 = *(const u32x4*)(K1 + g_ + 32 * 2048); vr0 = *(const u32x4*)(V1 + g_); vr1 = *(const u32x4*)(V1 + g_ + 32 * 2048); } while (0)
#define A_WRITE(buf) do { float s0_ = ssq8(kr0), s1_ = ssq8(kr1); \
            s0_ = row16_sum(s0_); s1_ = row16_sum(s1_); \
            const float r0_ = __builtin_amdgcn_rsqf(s0_ * (1.f / 128.f) + EPSF), r1_ = __builtin_amdgcn_rsqf(s1_ * (1.f / 128.f) + EPSF); \
            u32x4 k0_, k1_; \
            _Pragma("unroll") for (int e_ = 0; e_ < 4; ++e_) { k0_[e_] = pkbf(bflo(kr0[e_]) * r0_ * kgv[2 * e_], bfhi(kr0[e_]) * r0_ * kgv[2 * e_ + 1]); \
                k1_[e_] = pkbf(bflo(kr1[e_]) * r1_ * kgv[2 * e_], bfhi(kr1[e_]) * r1_ * kgv[2 * e_ + 1]); } \
            LAS unsigned char* bb_ = lds + (buf) * A_BUF; \
            *(LAS u32x4*)(bb_ + lrow * A_KSTR + lcc * 16) = k0_; *(LAS u32x4*)(bb_ + (lrow + 32) * A_KSTR + lcc * 16) = k1_; \
            *(LAS u32x4*)(bb_ + A_KT + lrow * A_VSTR + lcc * 16) = vr0; *(LAS u32x4*)(bb_ + A_KT + (lrow + 32) * A_VSTR + lcc * 16) = vr1; } while (0)
        A_ISSUE(A_KC(0));
        float bmx, bmn;
        { float v0 = rel[h * 257 + lane], v1 = rel[h * 257 + 64 + lane], v2 = rel[h * 257 + 128 + lane], v3 = rel[h * 257 + 192 + lane], v4 = rel[h * 257 + 256];
          bmx = fmaxf(fmaxf(fmaxf(v0, v1), fmaxf(v2, v3)), v4); bmn = fminf(fminf(fminf(v0, v1), fminf(v2, v3)), v4);
#pragma unroll
          for (int o = 1; o < 64; o <<= 1) { bmx = fmaxf(bmx, __shfl_xor(bmx, o)); bmn = fminf(bmn, __shfl_xor(bmn, o)); } }
        const float mfix = gmx + bmx * LOG2E;
        const bool fast = (2.f * gmx + (bmx - bmn) * LOG2E) <= 120.f;
        if (tid < 320) tab[tid] = rel[h * 257 + (tid < 256 ? tid : 256)] * LOG2E - mfix;
        bf16x8 Qf[2][4];
        {
            const float qsc = 0.08838834764831845f * LOG2E;
#pragma unroll
            for (int qt = 0; qt < 2; ++qt) {
                u32x4 raw[4]; float ss = 0.f;
                const bf16_t* qp = Q1 + (qrow0 + 16 * qt + fr) * 2048 + h * 128 + 8 * fq;
#pragma unroll
                for (int ks = 0; ks < 4; ++ks) { raw[ks] = *(const u32x4*)(qp + 32 * ks); ss += ssq8(raw[ks]); }
                ss += __shfl_xor(ss, 16); ss += __shfl_xor(ss, 32);
                const float rs = __builtin_amdgcn_rsqf(ss * (1.f / 128.f) + EPSF) * qsc;
#pragma unroll
                for (int ks = 0; ks < 4; ++ks) {
                    const f32x4 g0 = *(const f32x4*)(qg + 32 * ks + 8 * fq), g1 = *(const f32x4*)(qg + 32 * ks + 8 * fq + 4);
                    u32x4 pq;
                    pq.x = pkbf(bflo(raw[ks].x) * rs * g0[0], bfhi(raw[ks].x) * rs * g0[1]); pq.y = pkbf(bflo(raw[ks].y) * rs * g0[2], bfhi(raw[ks].y) * rs * g0[3]);
                    pq.z = pkbf(bflo(raw[ks].z) * rs * g1[0], bfhi(raw[ks].z) * rs * g1[1]); pq.w = pkbf(bflo(raw[ks].w) * rs * g1[2], bfhi(raw[ks].w) * rs * g1[3]);
                    Qf[qt][ks] = __builtin_bit_cast(bf16x8, pq);
                }
            }
        }
        f32x4 O[8][2];
#pragma unroll
        for (int nt = 0; nt < 8; ++nt) { O[nt][0] = (f32x4){0.f, 0.f, 0.f, 0.f}; O[nt][1] = O[nt][0]; }
        float mrun[2] = {-1e30f, -1e30f}, lsum[2] = {0.f, 0.f};
        A_WRITE(0);
        LDS_BARRIER();
        for (int t = 0; t < nst; ++t) {
            const int kc = A_KC(t);
            if (SH == 0 && t + 1 < nst) A_ISSUE(A_KC(t + 1));
            const int delta = jw - kc;
            if (kc >= 0 && delta >= 0 && delta <= 8) {
                const LAS unsigned char* kb = lds + (t & 1) * A_BUF;
                const LAS unsigned char* vb = kb + A_KT;
                f32x4 s[4][2];
                if (delta >= 3) { const float bc = tab[256];
#pragma unroll
                    for (int kt = 0; kt < 4; ++kt)
#pragma unroll
                        for (int qt = 0; qt < 2; ++qt) s[kt][qt] = (f32x4){bc, bc, bc, bc};
                } else {
                    const LAS float* tp = tab + (qoff + fr - 4 * fq + 128 - 51 + 64 * delta);
#pragma unroll
                    for (int kt = 0; kt < 4; ++kt)
#pragma unroll
                        for (int qt = 0; qt < 2; ++qt)
#pragma unroll
                            for (int r = 0; r < 4; ++r) s[kt][qt][r] = tp[16 * qt - 16 * kt - r + 51];
                }
#pragma unroll
                for (int kh = 0; kh < 2; ++kh) {
                    bf16x8 kf[2][4];
#pragma unroll
                    for (int kt = 0; kt < 2; ++kt)
#pragma unroll
                        for (int ks = 0; ks < 4; ++ks) kf[kt][ks] = *(const LAS bf16x8*)(kb + (16 * (2 * kh + kt) + fr) * A_KSTR + (32 * ks + 8 * fq) * 2);
#pragma unroll
                    for (int kt = 0; kt < 2; ++kt)
#pragma unroll
                        for (int qt = 0; qt < 2; ++qt) { f32x4 c = s[2 * kh + kt][qt];
#pragma unroll
                            for (int ks = 0; ks < 4; ++ks) c = mfma16(kf[kt][ks], Qf[qt][ks], c);
                            s[2 * kh + kt][qt] = c; }
                }
                if (SH == 3) { lsum[0] += s[0][0][0]; lsum[1] += s[0][1][0]; } else
                if (fast) {
#pragma unroll
                    for (int qt = 0; qt < 2; ++qt) { float ps = 0.f;
#pragma unroll
                        for (int kt = 0; kt < 4; ++kt)
#pragma unroll
                            for (int r = 0; r < 4; ++r) { const float p = ex2(s[kt][qt][r]); s[kt][qt][r] = p; ps += p; }
                        lsum[qt] += ps; }
                } else {
#pragma unroll
                    for (int qt = 0; qt < 2; ++qt) {
                        float mx = s[0][qt][0];
#pragma unroll
                        for (int kt = 0; kt < 4; ++kt)
#pragma unroll
                            for (int r = 0; r < 4; ++r) mx = fmaxf(mx, s[kt][qt][r]);
                        mx = fmaxf(mx, __shfl_xor(mx, 16)); mx = fmaxf(mx, __shfl_xor(mx, 32));
                        const float mn = fmaxf(mrun[qt], mx), alpha = ex2(mrun[qt] - mn); mrun[qt] = mn;
                        float ps = 0.f;
#pragma unroll
                        for (int kt = 0; kt < 4; ++kt)
#pragma unroll
                            for (int r = 0; r < 4; ++r) { const float p = ex2(s[kt][qt][r] - mn); s[kt][qt][r] = p; ps += p; }
                        lsum[qt] = lsum[qt] * alpha + ps;
#pragma unroll
                        for (int nt = 0; nt < 8; ++nt) O[nt][qt] = O[nt][qt] * alpha;
                    }
                }
#pragma unroll
                for (int s2 = 0; s2 < 2; ++s2) {
                    const bf16x8 pf0 = pack8(s[2 * s2][0], s[2 * s2 + 1][0]), pf1 = pack8(s[2 * s2][1], s[2 * s2 + 1][1]);
                    const LAS unsigned char* va = vb + (32 * s2 + 4 * fq + (fr >> 2)) * A_VSTR + 4 * (fr & 3) * 2;
#pragma unroll
                    for (int nt = 0; nt < 8; ++nt) {
                        const bf16x8 vfr = cat4(tr_read(va + nt * 32), tr_read(va + nt * 32 + 16 * A_VSTR));
                        O[nt][0] = mfma16(vfr, pf0, O[nt][0]); O[nt][1] = mfma16(vfr, pf1, O[nt][1]);
                    }
                }
            }
            if (SH < 2 && t + 1 < nst) A_WRITE((t + 1) & 1);
            if (SH != 4) LDS_BARRIER();
        }
#pragma unroll
        for (int qt = 0; qt < 2; ++qt) {
            float l = lsum[qt]; l += __shfl_xor(l, 16); l += __shfl_xor(l, 32);
            const float inv = 1.0f / l;
            if (SH == 0 || l == (float)magic)
            { bf16_t* op = Q1 + (qrow0 + 16 * qt + fr) * 2048 + h * 128 + 4 * fq;
#pragma unroll
            for (int nt = 0; nt < 8; ++nt) { u32x2 ow; ow.x = pkbf(O[nt][qt][0] * inv, O[nt][qt][1] * inv); ow.y = pkbf(O[nt][qt][2] * inv, O[nt][qt][3] * inv);
                *(u32x2*)(op + 16 * nt) = ow; } }
        }
#undef A_ISSUE
#undef A_KC
#undef A_WRITE
    }
}

struct Args { const float* x; const float* c; const int* pos; const float* norm_g; const float* ada_w; const float* ada_b; const float* ret_w_in; const float* ret_gn; const float* ret_w_out;
              const float* att_w_in; const float* att_qg; const float* att_kg; const float* att_rel; const float* att_w_out; float* out; unsigned char* ws; int ph_lo, ph_hi; };
constexpr int NPH = 11;

__global__ void __launch_bounds__(512, 2) mega_fwd(Args a) {
    extern __shared__ __attribute__((aligned(16))) unsigned char lds_raw[];
    __builtin_assume(__builtin_amdgcn_workitem_id_y() == 0); __builtin_assume(__builtin_amdgcn_workitem_id_z() == 0);
    LAS unsigned char* lds = (LAS unsigned char*)lds_raw;
    cg::grid_group grid = cg::this_grid();
    const int tid = threadIdx.x, lane = tid & 63, w = __builtin_amdgcn_readfirstlane(tid >> 6);
    const int G = gridDim.x, bid = blockIdx.x;
    const int vcu = (G % 8 == 0) ? (bid % 8) * (G / 8) + bid / 8 : bid;
    const int gw = bid * 8 + w, NGW = G * 8;
    unsigned char* ws = a.ws;
    bf16_t* H = (bf16_t*)(ws + WS_H);
    const float* mod = (const float*)(ws + WS_MOD);
    const int lo = a.ph_lo, hi = a.ph_hi;
#define IN(k) (lo <= (k) && (k) < hi)
#ifndef PROBE_MASK
#define PROBE_MASK 0
#endif
    unsigned long long t_prev = 0, t_acc = 0;
    if (PROBE_MASK) t_prev = __builtin_amdgcn_s_memrealtime();
#define SEAM(k) do { if (IN(k) && IN((k) + 1)) grid.sync(); if (PROBE_MASK) { const unsigned long long t_ = __builtin_amdgcn_s_memrealtime(); if ((PROBE_MASK >> (k)) & 1) t_acc += t_ - t_prev; t_prev = t_; } } while (0)
    if (IN(0)) p0_phase(lds, a.c, a.ada_w, a.ada_b, a.ret_w_in, a.ret_w_out, a.att_w_in, a.att_w_out, ws, bid, G);
    SEAM(0);
    if (IN(1)) { sw_items(lds, mod + 8 * 3072, a.att_w_in, 8192, (float*)(ws + WS_SW1), bid, G); ln_phase(a.x, H, a.norm_g, mod, gw, NGW, lane); }
    SEAM(1);
    if (IN(2)) {
        pg8::Gemm g{H, (const bf16_t*)(ws + WS_W0IN), NTOK, 4096, 1024}; pg8::StaticOrder S; S.init(NTOK, 4096, G, bid);
        EpiA0 E{(bf16_t*)(ws + WS_Q0), (bf16_t*)(ws + WS_K0), (bf16_t*)(ws + WS_V0), a.pos, (const float*)(ws + WS_INVF)};
        pg8::gemm_phase<EpiA0, pg8::StaticOrder, true, true>(lds, g, S, E);
    }
    SEAM(2);
    if (IN(3)) { ret_phase<0>(lds, (const bf16_t*)(ws + WS_Q0), (const bf16_t*)(ws + WS_K0), (bf16_t*)(ws + WS_V0), (float*)(ws + WS_SSQ), vcu, G, lo - 1);
        if (PROBE_SHADOW >= 10) ret_phase<PROBE_SHADOW - 9>(lds, (const bf16_t*)(ws + WS_Q0), (const bf16_t*)(ws + WS_K0), (bf16_t*)(ws + WS_V0), (float*)(ws + WS_SSQ), vcu, G, lo - 1); }
    SEAM(3);
    if (IN(4)) {
        pg8::Gemm g{H, (const bf16_t*)(ws + WS_W0IN) + (size_t)4096 * 1024, NTOK, 2048, 1024}; pg8::StaticOrder S; S.init(NTOK, 2048, G, bid);
        EpiG<0> E{(bf16_t*)(ws + WS_V0), (const float*)(ws + WS_SSQ), a.ret_gn, nullptr};
        pg8::gemm_phase<EpiG<0>, pg8::StaticOrder, true, true>(lds, g, S, E);
    }
    SEAM(4);
    if (IN(5)) {
        pg8::Gemm g{(const bf16_t*)(ws + WS_V0), (const bf16_t*)(ws + WS_W0OUT), NTOK, 1024, 2048}; pg8::StaticOrder S; S.init(NTOK, 1024, G, bid);
        EpiOutLN E{a.x, a.out, mod + 2048, H, a.norm_g + 1024, mod + 8 * 3072 + 1024, (float*)(ws + WS_SSQ), (LAS float*)(lds + 131072)};
        pg8::gemm_phase<EpiOutLN, pg8::StaticOrder, true, true>(lds, g, S, E);
    }
    SEAM(5);
    if (IN(7)) {
        pg8::Gemm g{H, (const bf16_t*)(ws + WS_W1IN), NTOK, 6144, 1024}; pg8::StaticOrder S; S.init(NTOK, 6144, G, bid);
        EpiA1 E{(bf16_t*)(ws + WS_Q1), (const float*)(ws + WS_SSQ), (const float*)(ws + WS_SW1)};
        pg8::gemm_phase<EpiA1, pg8::StaticOrder, true, true>(lds, g, S, E);
    }
    SEAM(7);
    if (IN(8)) { att_phase<0>(lds, (bf16_t*)(ws + WS_Q1), (const bf16_t*)(ws + WS_K1), (const bf16_t*)(ws + WS_V1), a.att_qg, a.att_kg, a.att_rel, vcu, G, lo - 1);
        if (PROBE_SHADOW >= 1 && PROBE_SHADOW < 10) att_phase<(PROBE_SHADOW < 10 ? PROBE_SHADOW : 1)>(lds, (bf16_t*)(ws + WS_Q1), (const bf16_t*)(ws + WS_K1), (const bf16_t*)(ws + WS_V1), a.att_qg, a.att_kg, a.att_rel, vcu, G, lo - 1); }
    SEAM(8);
    if (IN(9)) {
        pg8::Gemm g{H, (const bf16_t*)(ws + WS_W1IN) + (size_t)6144 * 1024, NTOK, 2048, 1024}; pg8::StaticOrder S; S.init(NTOK, 2048, G, bid);
        EpiG<1> E{(bf16_t*)(ws + WS_Q1), (const float*)(ws + WS_SSQ), nullptr, (const float*)(ws + WS_SW1)};
        pg8::gemm_phase<EpiG<1>, pg8::StaticOrder, true, true>(lds, g, S, E);
    }
    SEAM(9);
    if (IN(10)) {
        pg8::Gemm g{(const bf16_t*)(ws + WS_Q1), (const bf16_t*)(ws + WS_W1OUT), NTOK, 1024, 2048}; pg8::StaticOrder S; S.init(NTOK, 1024, G, bid);
        EpiOut E{a.out, a.out, mod + 8 * 3072 + 2048};
        pg8::gemm_phase<EpiOut, pg8::StaticOrder, true, true>(lds, g, S, E);
    }
    if (PROBE_MASK) { const unsigned long long t_ = __builtin_amdgcn_s_memrealtime(); if ((PROBE_MASK >> 10) & 1) t_acc += t_ - t_prev;
        if (bid == 0 && tid == 0) { while (__builtin_amdgcn_s_memrealtime() - t_ < t_acc) __builtin_amdgcn_s_sleep(8); } }
#undef IN
#undef SEAM
}

extern "C" void kernel_launch(void* const* d_in, const int* in_sizes, int n_in, void* d_out, int out_size, void* d_ws, size_t ws_size, hipStream_t stream) {
    static int grid = 0;
    if (grid == 0) {
        if (n_in != 14 || out_size != NTOK * DM || ws_size < WS_END) { fprintf(stderr, "kernel_launch: unexpected shapes (n_in %d out %d ws %zu need %zu)\n", n_in, out_size, ws_size, (size_t)WS_END); grid = -1; return; }
        int dev = 0, cus = 0, per_cu = 0;
        hipGetDevice(&dev);
        hipDeviceGetAttribute(&cus, hipDeviceAttributeMultiprocessorCount, dev);
        if (hipFuncSetAttribute((const void*)mega_fwd, hipFuncAttributeMaxDynamicSharedMemorySize, LDS_BYTES) != hipSuccess) { fprintf(stderr, "kernel_launch: hipFuncSetAttribute failed\n"); grid = -1; return; }
        if (hipOccupancyMaxActiveBlocksPerMultiprocessor(&per_cu, (const void*)mega_fwd, 512, LDS_BYTES) != hipSuccess || per_cu < 1) { fprintf(stderr, "kernel_launch: occupancy query says %d\n", per_cu); per_cu = 1; }
        (void)hipGetLastError();
        grid = cus * per_cu;
    }
    if (grid < 0) return;
    Args a{};
    a.x = (const float*)d_in[0]; a.c = (const float*)d_in[1]; a.pos = (const int*)d_in[2]; a.norm_g = (const float*)d_in[3]; a.ada_w = (const float*)d_in[4]; a.ada_b = (const float*)d_in[5];
    a.ret_w_in = (const float*)d_in[6]; a.ret_gn = (const float*)d_in[7]; a.ret_w_out = (const float*)d_in[8]; a.att_w_in = (const float*)d_in[9]; a.att_qg = (const float*)d_in[10];
    a.att_kg = (const float*)d_in[11]; a.att_rel = (const float*)d_in[12]; a.att_w_out = (const float*)d_in[13]; a.out = (float*)d_out; a.ws = (unsigned char*)d_ws;
#if MK_N_LAUNCHES == 1
    a.ph_lo = 0; a.ph_hi = NPH;
    void* args[] = {&a};
    hipError_t e = hipLaunchCooperativeKernel((const void*)mega_fwd, dim3(grid), dim3(512), args, LDS_BYTES, stream);
    if (e != hipSuccess) fprintf(stderr, "kernel_launch: cooperative launch failed: %s (grid %d)\n", hipGetErrorString(e), grid);
#else
    for (int p = 0; p < NPH; ++p) { a.ph_lo = p; a.ph_hi = p + 1; hipLaunchKernelGGL(mega_fwd, dim3(grid), dim3(512), LDS_BYTES, stream, a); }
#endif
}
```

```cpp
#include <hip/hip_runtime.h>
#include <hip/hip_cooperative_groups.h>
#include <cstdio>
#include <cstdint>
namespace cg = cooperative_groups;

#ifndef MK_N_LAUNCHES
#define MK_N_LAUNCHES 1
#endif
#ifndef PROBE_MASK
#define PROBE_MASK 0
#endif
#define PROBE_SHADOW 0

namespace pg8 {
#define PG8_LAS __attribute__((address_space(3)))
typedef unsigned short bf16_t;
typedef short bf16x8 __attribute__((ext_vector_type(8)));
typedef float f32x4 __attribute__((ext_vector_type(4)));
typedef unsigned u32x4 __attribute__((ext_vector_type(4)));
constexpr int BM = 256, BK = 64, HALF = 128, HTB = HALF * BK * 2  , STAGE_BYTES = 8 * HTB, NXCD = 8, WGM = 8;

__host__ __device__ __forceinline__ int lds_byte(int r, int c) { const int st = (r >> 4) * 2 + (c >> 5), rr = r & 15, cc = c & 31, ob = rr * 64 + cc * 2; return st * 1024 + (ob ^ (((ob >> 9) & 1) << 5)); }
__host__ __device__ __forceinline__ void stage_rc(int b, int& R, int& C) { const int st = b / 1024, sb = b % 1024, swz = sb ^ (((sb >> 9) & 1) << 5); R = (st >> 1) * 16 + swz / 64; C = (st & 1) * 32 + (swz % 64) / 2; }
__host__ __device__ __forceinline__ int perm32(int rho) { const int n = rho >> 4, i = rho & 15; return 8 * (i >> 2) + 4 * n + (i & 3); }

struct Unit { int pm, pn; };
struct Gemm { const bf16_t* A; const bf16_t* Bt; int M, N, K; };

struct StaticOrder {
    int nM, nN, nwg, G, c;
    __host__ __device__ void init(int M, int N, int G_, int c_) { nM = M / BM; nN = N / BM; nwg = nM * nN; G = G_; c = c_; }
    __host__ __device__ bool next(int i, Unit& u) const {
        const long L = (long)i * G + c; if (L >= nwg) return false;
        int wgid = (int)L; { const int q = nwg / NXCD, r = nwg % NXCD, xcd = wgid % NXCD, off = wgid / NXCD; wgid = (xcd < r ? xcd * (q + 1) : r * (q + 1) + (xcd - r) * q) + off; }
        const int nig = WGM * nN, gid = wgid / nig, fm = gid * WGM, gsz = (nM - fm) < WGM ? (nM - fm) : WGM;
        u.pm = fm + ((wgid % nig) % gsz); u.pn = (wgid % nig) / gsz; return true;
    }
    __device__ __forceinline__ void a_ready(const Unit&) const {}
    __device__ __forceinline__ void done(const Unit&) const {}
};

__device__ __forceinline__ unsigned cvt_pk_bf16(float lo, float hi) { unsigned r; asm volatile("v_cvt_pk_bf16_f32 %0, %1, %2" : "=v"(r) : "v"(lo), "v"(hi)); return r; }
template <class Epi, class Sched, bool ALIGN_EPI = false, bool SP2 = false>
__device__ __forceinline__ void gemm_phase(PG8_LAS unsigned char* lds, const Gemm g, const Sched& S, const Epi& E) {
    const int tid = threadIdx.x, wid = __builtin_amdgcn_readfirstlane(tid >> 6), lane = tid & 63, wr = wid >> 2, wc = wid & 3, fr = lane & 15, fq = lane >> 4;
    const int K = g.K, nt = K / BK;
    unsigned voffA[2], voffB[2];
#pragma unroll
    for (int i = 0; i < 2; ++i) { int R, C; stage_rc(tid * 16 + i * 8192, R, C); const int Rb = Epi::PERM ? ((R & ~31) + perm32(R & 31)) : R;
        voffA[i] = (unsigned)(R * K + C) * 2u; voffB[i] = (unsigned)(Rb * K + C) * 2u; }
    const size_t kstep = (size_t)(BK * 2);
    const size_t hstep = (size_t)HALF * K * 2;
    const size_t tstep = 2 * hstep;
    const unsigned ldsw = (unsigned)wid * 1024u;
    const int aoff = lds_byte(wr * 64 + fr, fq * 8), boff = lds_byte(wc * 32 + fr, fq * 8);
#define PG8_SA(b, h) (((b) * 2 + (h)) * HTB)
#define PG8_SB(b, h) ((4 + (b) * 2 + (h)) * HTB)
#define PG8_STAGE(bufoff, gbase, voff) do { _Pragma("unroll") for (int _i = 0; _i < 2; ++_i) \
        __builtin_amdgcn_global_load_lds((const unsigned*)((const char*)(gbase) + (voff)[_i]), (PG8_LAS unsigned*)(lds + (bufoff) + ldsw + _i * 8192), 16, 0, 0); } while (0)
#define PG8_LDA(dst, b, h) do { _Pragma("unroll") for (int m = 0; m < 4; ++m) _Pragma("unroll") for (int k = 0; k < 2; ++k) dst[m][k] = *(const PG8_LAS bf16x8*)(lds + PG8_SA(b, h) + aoff + m * 2048 + k * 1024); } while (0)
#define PG8_LDB(dst, b, h) do { _Pragma("unroll") for (int n = 0; n < 2; ++n) _Pragma("unroll") for (int k = 0; k < 2; ++k) dst[n][k] = *(const PG8_LAS bf16x8*)(lds + PG8_SB(b, h) + boff + n * 2048 + k * 1024); } while (0)
#define PG8_MMA(ai, bj, At, Bt) do { __builtin_amdgcn_s_setprio(1); _Pragma("unroll") for (int m = 0; m < 4; ++m) _Pragma("unroll") for (int n = 0; n < 2; ++n) _Pragma("unroll") for (int k = 0; k < 2; ++k) \
        acc[ai][bj][m][n] = __builtin_amdgcn_mfma_f32_16x16x32_bf16(Bt[n][k], At[m][k], acc[ai][bj][m][n], 0, 0, 0); __builtin_amdgcn_s_setprio(0); } while (0)
#define PG8_WAIT_V(n) asm volatile("s_waitcnt vmcnt(" #n ")" ::: "memory")
#define PG8_WAIT_L(n) asm volatile("s_waitcnt lgkmcnt(" #n ")" ::: "memory")
#define PG8_BAR __builtin_amdgcn_s_barrier()
#define PG8_SCHED __builtin_amdgcn_sched_barrier(0)
    Unit cur, nxt; int ui = 0;
    if (!S.next(0, cur)) return;
    f32x4 acc[2][2][4][2];
#pragma unroll
    for (int a = 0; a < 2; ++a)
#pragma unroll
        for (int b = 0; b < 2; ++b)
#pragma unroll
            for (int m = 0; m < 4; ++m)
#pragma unroll
                for (int n = 0; n < 2; ++n) acc[a][b][m][n] = (f32x4){0.f, 0.f, 0.f, 0.f};
    bf16x8 At[4][2], B0[2][2], B1[2][2];
    const char* cA = (const char*)g.A + (size_t)cur.pm * tstep; const char* cB = (const char*)g.Bt + (size_t)cur.pn * tstep;
    S.a_ready(cur);
    if constexpr (SP2) {
        PG8_STAGE(PG8_SB(0, 0), cB, voffB); PG8_STAGE(PG8_SB(0, 1), cB + hstep, voffB); PG8_STAGE(PG8_SA(0, 0), cA, voffA); PG8_STAGE(PG8_SA(0, 1), cA + hstep, voffA);
        if (wr == 1) PG8_BAR;
        PG8_WAIT_V(2); PG8_BAR;
        PG8_STAGE(PG8_SB(1, 0), cB + kstep, voffB); PG8_STAGE(PG8_SA(1, 0), cA + kstep, voffA); PG8_STAGE(PG8_SB(1, 1), cB + hstep + kstep, voffB);
        PG8_WAIT_V(6); PG8_BAR;
    } else {
        PG8_STAGE(PG8_SB(0, 0), cB, voffB); PG8_STAGE(PG8_SA(0, 0), cA, voffA); PG8_STAGE(PG8_SB(0, 1), cB + hstep, voffB); PG8_STAGE(PG8_SA(0, 1), cA + hstep, voffA);
        if (wr == 1) PG8_BAR;
        PG8_WAIT_V(4); PG8_BAR;
        PG8_STAGE(PG8_SB(1, 0), cB + kstep, voffB); PG8_STAGE(PG8_SA(1, 0), cA + kstep, voffA); PG8_STAGE(PG8_SB(1, 1), cB + hstep + kstep, voffB);
        PG8_WAIT_V(6); PG8_BAR;
    }
    for (;;) {
        const bool has_next = S.next(ui + 1, nxt);
        const char* nA = has_next ? (const char*)g.A + (size_t)nxt.pm * tstep : cA; const char* nB = has_next ? (const char*)g.Bt + (size_t)nxt.pn * tstep : cB;
        for (int t = 0; t < nt; t += 2) {
            const bool last = (t == nt - 2);
            const char* a1 = cA + (size_t)(t + 1) * kstep;
            const char* a2 = last ? nA : cA + (size_t)(t + 2) * kstep; const char* b2 = last ? nB : cB + (size_t)(t + 2) * kstep;
            const char* a3 = a2 + kstep; const char* b3 = b2 + kstep;
            if (last && has_next) S.a_ready(nxt);
            if constexpr (SP2) {
            PG8_LDB(B0, 0, 0); PG8_LDB(B1, 0, 1); PG8_SCHED; PG8_LDA(At, 0, 0); PG8_STAGE(PG8_SA(1, 1), a1 + hstep, voffA);
            PG8_WAIT_V(8); PG8_WAIT_L(0); PG8_BAR; PG8_MMA(0, 0, At, B0); PG8_MMA(0, 1, At, B1); PG8_BAR; PG8_SCHED;
            PG8_LDA(At, 0, 1); PG8_STAGE(PG8_SB(0, 0), b2, voffB); PG8_STAGE(PG8_SB(0, 1), b2 + hstep, voffB); PG8_STAGE(PG8_SA(0, 0), a2, voffA);
            PG8_WAIT_V(8); PG8_WAIT_L(0); PG8_BAR; PG8_MMA(1, 0, At, B0); PG8_MMA(1, 1, At, B1); PG8_BAR; PG8_SCHED;
            PG8_LDB(B0, 1, 0); PG8_LDB(B1, 1, 1); PG8_SCHED; PG8_LDA(At, 1, 0); PG8_STAGE(PG8_SA(0, 1), a2 + hstep, voffA);
            PG8_WAIT_V(8); PG8_WAIT_L(0); PG8_BAR; PG8_MMA(0, 0, At, B0); PG8_MMA(0, 1, At, B1); PG8_BAR; PG8_SCHED;
            PG8_LDA(At, 1, 1); PG8_STAGE(PG8_SB(1, 0), b3, voffB); PG8_STAGE(PG8_SB(1, 1), b3 + hstep, voffB); PG8_STAGE(PG8_SA(1, 0), a3, voffA);
            PG8_WAIT_V(8); PG8_WAIT_L(0); PG8_BAR; PG8_MMA(1, 0, At, B0); PG8_MMA(1, 1, At, B1); PG8_BAR; PG8_SCHED;
            } else {
            PG8_LDB(B0, 0, 0); PG8_SCHED; PG8_LDA(At, 0, 0); PG8_STAGE(PG8_SA(1, 1), a1 + hstep, voffA);
            PG8_WAIT_L(8); PG8_BAR; PG8_WAIT_L(0); PG8_MMA(0, 0, At, B0); PG8_BAR; PG8_SCHED;
            PG8_LDB(B1, 0, 1); PG8_STAGE(PG8_SB(0, 0), b2, voffB);
            PG8_BAR; PG8_WAIT_L(0); PG8_MMA(0, 1, At, B1); PG8_BAR;
            PG8_LDA(At, 0, 1); PG8_STAGE(PG8_SA(0, 0), a2, voffA);
            PG8_BAR; PG8_WAIT_L(0); PG8_MMA(1, 0, At, B0); PG8_BAR; PG8_SCHED;
            PG8_STAGE(PG8_SB(0, 1), b2 + hstep, voffB);
            PG8_WAIT_V(6); PG8_BAR; PG8_MMA(1, 1, At, B1); PG8_BAR;
            PG8_LDB(B0, 1, 0); PG8_SCHED; PG8_LDA(At, 1, 0); PG8_STAGE(PG8_SA(0, 1), a2 + hstep, voffA);
            PG8_WAIT_L(8); PG8_BAR; PG8_WAIT_L(0); PG8_MMA(0, 0, At, B0); PG8_BAR; PG8_SCHED;
            PG8_LDB(B1, 1, 1); PG8_STAGE(PG8_SB(1, 0), b3, voffB);
            PG8_BAR; PG8_WAIT_L(0); PG8_MMA(0, 1, At, B1); PG8_BAR;
            PG8_LDA(At, 1, 1); PG8_STAGE(PG8_SA(1, 0), a3, voffA);
            PG8_BAR; PG8_WAIT_L(0); PG8_MMA(1, 0, At, B0); PG8_BAR; PG8_SCHED;
            PG8_STAGE(PG8_SB(1, 1), b3 + hstep, voffB);
            PG8_WAIT_V(6); PG8_BAR; PG8_MMA(1, 1, At, B1); PG8_BAR;
            }
        }
        if constexpr (ALIGN_EPI) { if (wr == 0) PG8_BAR; }
        if constexpr (!Epi::AFTER_DRAIN) { E(acc, cur, wr, wc, fr, fq); S.done(cur); }
        if (!has_next) break;
#pragma unroll
        for (int a = 0; a < 2; ++a)
#pragma unroll
            for (int b = 0; b < 2; ++b)
#pragma unroll
                for (int m = 0; m < 4; ++m)
#pragma unroll
                    for (int n = 0; n < 2; ++n) acc[a][b][m][n] = (f32x4){0.f, 0.f, 0.f, 0.f};
        cur = nxt; cA = nA; cB = nB; ++ui;
        if constexpr (ALIGN_EPI) { if (wr == 1) PG8_BAR; }
    }
    PG8_WAIT_V(0);
    if constexpr (!ALIGN_EPI) { if (wr == 0) PG8_BAR; }
    PG8_BAR;
    if constexpr (Epi::AFTER_DRAIN) { E.fused(acc, cur, wr, wc, fr, fq, lds, wid, lane); S.done(cur); }
#undef PG8_SA
#undef PG8_SB
#undef PG8_STAGE
#undef PG8_LDA
#undef PG8_LDB
#undef PG8_MMA
#undef PG8_WAIT_V
#undef PG8_WAIT_L
#undef PG8_BAR
#undef PG8_SCHED
}
}

#define LAS __attribute__((address_space(3)))
#define DI __device__ __forceinline__
typedef unsigned short bf16_t;
typedef short bf16x8 __attribute__((ext_vector_type(8)));
typedef short s16x4 __attribute__((ext_vector_type(4)));
typedef short v4i16_t __attribute__((ext_vector_type(4)));
typedef float f32x4 __attribute__((ext_vector_type(4)));
typedef float f32x2_t __attribute__((ext_vector_type(2)));
typedef __bf16 bf16x2_t __attribute__((ext_vector_type(2)));
typedef unsigned u32x4 __attribute__((ext_vector_type(4)));
typedef unsigned u32x2 __attribute__((ext_vector_type(2)));

constexpr int NTOK = 65536, DM = 1024, SEQ = 8192;
constexpr size_t MiB = 1u << 20;
constexpr size_t WS_MOD = 0;
constexpr size_t WS_INVF = 256 * 1024;
constexpr size_t WS_SW1 = 512 * 1024;
constexpr size_t WS_W0IN = 1 * MiB, WS_W0OUT = 13 * MiB, WS_W1IN = 17 * MiB, WS_W1OUT = 33 * MiB;
constexpr size_t WS_SSQ = 37 * MiB;
constexpr size_t WS_H = 48 * MiB;
constexpr size_t WS_ACT = 176 * MiB;
constexpr size_t WS_Q0 = WS_ACT, WS_K0 = WS_ACT + 128 * MiB, WS_V0 = WS_ACT + 256 * MiB;
constexpr size_t WS_Q1 = WS_ACT, WS_K1 = WS_ACT + 256 * MiB, WS_V1 = WS_ACT + 512 * MiB;
constexpr size_t WS_END = WS_ACT + 768 * MiB;
constexpr int LDS_BYTES = 147456;
constexpr float EPSF = 1e-6f;

DI unsigned pkbf(float lo, float hi) { f32x2_t v = {lo, hi}; bf16x2_t b = __builtin_convertvector(v, bf16x2_t); return __builtin_bit_cast(unsigned, b); }
DI float bflo(unsigned u) { return __builtin_bit_cast(float, u << 16); }
DI float bfhi(unsigned u) { return __builtin_bit_cast(float, u & 0xffff0000u); }
DI float ex2(float x) { return __builtin_amdgcn_exp2f(x); }
DI f32x4 mfma16(bf16x8 a, bf16x8 b, f32x4 c) { return __builtin_amdgcn_mfma_f32_16x16x32_bf16(a, b, c, 0, 0, 0); }
DI s16x4 tr_read(const LAS unsigned char* p) { return __builtin_bit_cast(s16x4, __builtin_amdgcn_ds_read_tr16_b64_v4i16((LAS v4i16_t*)p)); }
DI bf16x8 cat4(s16x4 lo, s16x4 hi) { return __builtin_shufflevector(lo, hi, 0, 1, 2, 3, 4, 5, 6, 7); }
DI bf16x8 pack8(f32x4 a, f32x4 b) { u32x4 p; p.x = pkbf(a[0], a[1]); p.y = pkbf(a[2], a[3]); p.z = pkbf(b[0], b[1]); p.w = pkbf(b[2], b[3]); return __builtin_bit_cast(bf16x8, p); }
DI float silu_f(float g) { return g * __builtin_amdgcn_rcpf(1.f + ex2(-1.4426950408889634f * g)); }
#define LDS_BARRIER() do { asm volatile("s_waitcnt lgkmcnt(0)" ::: "memory"); __builtin_amdgcn_s_barrier(); asm volatile("" ::: "memory"); } while (0)
DI float wave_sum(float v) {
#pragma unroll
    for (int o = 1; o < 64; o <<= 1) v += __shfl_xor(v, o);
    return v;
}
DI float dpp_f(float v, const int ctrl_sel) {
    const int x = __builtin_bit_cast(int, v); int r;
    if (ctrl_sel == 0) r = __builtin_amdgcn_update_dpp(x, x, 0xB1, 0xF, 0xF, false);
    else if (ctrl_sel == 1) r = __builtin_amdgcn_update_dpp(x, x, 0x4E, 0xF, 0xF, false);
    else if (ctrl_sel == 2) r = __builtin_amdgcn_update_dpp(x, x, 0x141, 0xF, 0xF, false);
    else r = __builtin_amdgcn_update_dpp(x, x, 0x140, 0xF, 0xF, false);
    return __builtin_bit_cast(float, r); }
DI float row16_sum(float v) { v += dpp_f(v, 0); v += dpp_f(v, 1); v += dpp_f(v, 2); v += dpp_f(v, 3); return v; }
DI float ssq8(u32x4 v) { float s = 0.f;
#pragma unroll
    for (int e = 0; e < 4; ++e) { const float a = bflo(v[e]), b = bfhi(v[e]); s += a * a + b * b; }
    return s; }

typedef const f32x4 (&AccRef)[2][2][4][2];
constexpr float INV2PI_HI = 0.15915493667125702f, INV2PI_LO = 6.4206382432985265e-09f;

struct EpiA0 {
    static constexpr bool PERM = true, AFTER_DRAIN = false;
    bf16_t *Q, *K, *V; const int* pos; const float* invf;
    DI void operator()(AccRef acc, const pg8::Unit& u, int wr, int wc, int fr, int fq) const {
        const int row0 = u.pm * 256 + wr * 64 + fr;
        if (u.pn < 8) {
            bf16_t* base = (u.pn < 4 ? Q : K) + (u.pn & 3) * 256;
            const float sc = u.pn < 4 ? 1.f : 0.0625f;
            const int cl = wc * 32 + 8 * fq;
            const f32x4 f0 = *(const f32x4*)(invf + cl), f1 = *(const f32x4*)(invf + cl + 4);
#pragma unroll
            for (int ai = 0; ai < 2; ++ai)
#pragma unroll
                for (int m = 0; m < 4; ++m) {
                    const int row = row0 + ai * 128 + m * 16;
                    const float p = (float)pos[row];
                    float o1[8], o2[8];
#pragma unroll
                    for (int n = 0; n < 2; ++n)
#pragma unroll
                        for (int i = 0; i < 4; ++i) {
                            const float ang = p * (n == 0 ? f0[i] : f1[i]);
                            const float hi = ang * INV2PI_HI;
                            float lo = __builtin_fmaf(ang, INV2PI_HI, -hi); lo = __builtin_fmaf(ang, INV2PI_LO, lo);
                            const float r = __builtin_amdgcn_fractf(hi) + lo;
                            const float s = __builtin_amdgcn_sinf(r), c = __builtin_amdgcn_cosf(r);
                            const float t1 = acc[ai][0][m][n][i], t2 = acc[ai][1][m][n][i];
                            o1[4 * n + i] = (t1 * c - t2 * s) * sc; o2[4 * n + i] = (t1 * s + t2 * c) * sc;
                        }
                    bf16_t* rp = base + (size_t)row * 1024 + cl;
                    u32x4 w1, w2;
                    w1.x = pkbf(o1[0], o1[1]); w1.y = pkbf(o1[2], o1[3]); w1.z = pkbf(o1[4], o1[5]); w1.w = pkbf(o1[6], o1[7]);
                    w2.x = pkbf(o2[0], o2[1]); w2.y = pkbf(o2[2], o2[3]); w2.z = pkbf(o2[4], o2[5]); w2.w = pkbf(o2[6], o2[7]);
                    *(u32x4*)rp = w1; *(u32x4*)(rp + 128) = w2;
                }
        } else {
            const int col0 = (u.pn - 8) * 256 + wc * 32 + 8 * fq;
#pragma unroll
            for (int ai = 0; ai < 2; ++ai)
#pragma unroll
                for (int m = 0; m < 4; ++m) {
                    bf16_t* rp = V + (size_t)(row0 + ai * 128 + m * 16) * 2048 + col0;
#pragma unroll
                    for (int bj = 0; bj < 2; ++bj) { const f32x4 v0 = acc[ai][bj][m][0], v1 = acc[ai][bj][m][1];
                        u32x4 w; w.x = pkbf(v0[0], v0[1]); w.y = pkbf(v0[2], v0[3]); w.z = pkbf(v1[0], v1[1]); w.w = pkbf(v1[2], v1[3]);
                        *(u32x4*)(rp + bj * 128) = w; }
                }
        }
    }
};

DI float rstd16(const float* ssq1, int row) {
    const f32x4 a = *(const f32x4*)(ssq1 + (size_t)row * 4);
    return __builtin_amdgcn_rsqf(((a[0] + a[1]) + (a[2] + a[3])) * (1.f / 1024.f) + EPSF);
}
struct EpiA1 {
    static constexpr bool PERM = true, AFTER_DRAIN = false;
    bf16_t* Q; const float* ssq1; const float* sw;
    DI void operator()(AccRef acc, const pg8::Unit& u, int wr, int wc, int fr, int fq) const {
        const int row0 = u.pm * 256 + wr * 64 + fr;
        bf16_t* base = Q + (size_t)(u.pn >> 3) * ((size_t)NTOK * 2048);
        const int col0 = (u.pn & 7) * 256 + wc * 32 + 8 * fq;
        const float* swp = sw + (size_t)(u.pm >> 5) * 8192 + u.pn * 256 + wc * 32 + 8 * fq;
        f32x4 sv[2][2];
#pragma unroll
        for (int bj = 0; bj < 2; ++bj) { sv[bj][0] = *(const f32x4*)(swp + bj * 128); sv[bj][1] = *(const f32x4*)(swp + bj * 128 + 4); }
#pragma unroll
        for (int ai = 0; ai < 2; ++ai)
#pragma unroll
            for (int m = 0; m < 4; ++m) {
                const int row = row0 + ai * 128 + m * 16;
                const float rs = rstd16(ssq1, row);
                bf16_t* rp = base + (size_t)row * 2048 + col0;
#pragma unroll
                for (int bj = 0; bj < 2; ++bj) { const f32x4 v0 = acc[ai][bj][m][0] * rs + sv[bj][0], v1 = acc[ai][bj][m][1] * rs + sv[bj][1];
                    u32x4 w; w.x = pkbf(v0[0], v0[1]); w.y = pkbf(v0[2], v0[3]); w.z = pkbf(v1[0], v1[1]); w.w = pkbf(v1[2], v1[3]);
                    *(u32x4*)(rp + bj * 128) = w; }
            }
    }
};

template <int L> struct EpiG {
    static constexpr bool PERM = true, AFTER_DRAIN = false;
    bf16_t* O; const float* ssq; const float* gn; const float* sw;
    DI void operator()(AccRef acc, const pg8::Unit& u, int wr, int wc, int fr, int fq) const {
        const int row0 = u.pm * 256 + wr * 64 + fr;
        const int col0 = u.pn * 256 + wc * 32 + 8 * fq, head = u.pn >> 1;
        float gnv[2][8];
#pragma unroll
        for (int bj = 0; bj < 2; ++bj)
#pragma unroll
            for (int e = 0; e < 8; ++e) gnv[bj][e] = (L == 0) ? gn[col0 + bj * 128 + e] : 1.f;
#pragma unroll
        for (int ai = 0; ai < 2; ++ai)
#pragma unroll
            for (int m = 0; m < 4; ++m) {
                const int row = row0 + ai * 128 + m * 16;
                float rstd = 1.f, rs1 = 1.f;
                if (L == 1) rs1 = rstd16(ssq, row);
                if (L == 0) { const float* sp = ssq + ((size_t)row * 4 + head) * 8; const f32x4 s0 = *(const f32x4*)sp, s1 = *(const f32x4*)(sp + 4);
                    const float tot = ((s0[0] + s0[1]) + (s0[2] + s0[3])) + ((s1[0] + s1[1]) + (s1[2] + s1[3]));
                    rstd = __builtin_amdgcn_rsqf(tot * (1.f / 512.f) + EPSF); }
                bf16_t* rp = O + (size_t)row * 2048 + col0;
#pragma unroll
                for (int bj = 0; bj < 2; ++bj) {
                    const u32x4 ov = *(const u32x4*)(rp + bj * 128);
                    f32x4 g0 = acc[ai][bj][m][0], g1 = acc[ai][bj][m][1];
                    if (L == 1) { const float* swp = sw + (size_t)(u.pm >> 5) * 8192 + 6144 + col0 + bj * 128; g0 = g0 * rs1 + *(const f32x4*)swp; g1 = g1 * rs1 + *(const f32x4*)(swp + 4); }
                    float r[8];
#pragma unroll
                    for (int e = 0; e < 4; ++e) { const float ga = (e < 2 ? g0[2 * e] : g1[2 * e - 4]), gb = (e < 2 ? g0[2 * e + 1] : g1[2 * e - 3]);
                        r[2 * e] = bflo(ov[e]) * silu_f(ga) * (rstd * gnv[bj][2 * e]); r[2 * e + 1] = bfhi(ov[e]) * silu_f(gb) * (rstd * gnv[bj][2 * e + 1]); }
                    u32x4 w; w.x = pkbf(r[0], r[1]); w.y = pkbf(r[2], r[3]); w.z = pkbf(r[4], r[5]); w.w = pkbf(r[6], r[7]);
                    *(u32x4*)(rp + bj * 128) = w;
                }
            }
    }
};

struct EpiOut {
    static constexpr bool PERM = true, AFTER_DRAIN = false;
    const float* xin; float* xout; const float* gate;
    DI void operator()(AccRef acc, const pg8::Unit& u, int wr, int wc, int fr, int fq) const {
        const int row0 = u.pm * 256 + wr * 64 + fr;
        const int col0 = u.pn * 256 + wc * 32 + 8 * fq;
        const float* gp = gate + (size_t)(u.pm >> 5) * 3072 + col0;
        f32x4 gv[2][2];
#pragma unroll
        for (int bj = 0; bj < 2; ++bj) { gv[bj][0] = *(const f32x4*)(gp + bj * 128); gv[bj][1] = *(const f32x4*)(gp + bj * 128 + 4); }
#pragma unroll
        for (int ai = 0; ai < 2; ++ai)
#pragma unroll
            for (int m = 0; m < 4; ++m) {
                const size_t off = (size_t)(row0 + ai * 128 + m * 16) * 1024 + col0;
#pragma unroll
                for (int bj = 0; bj < 2; ++bj) {
                    const f32x4 x0 = *(const f32x4*)(xin + off + bj * 128), x1 = *(const f32x4*)(xin + off + bj * 128 + 4);
                    *(f32x4*)(xout + off + bj * 128) = x0 + gv[bj][0] * acc[ai][bj][m][0];
                    *(f32x4*)(xout + off + bj * 128 + 4) = x1 + gv[bj][1] * acc[ai][bj][m][1];
                }
            }
    }
};

struct EpiOutLN {
    static constexpr bool PERM = true, AFTER_DRAIN = false;
    const float* xin; float* xout; const float* gate; bf16_t* H; const float* g1; const float* scale1; float* ssq1; LAS float* red;
    DI void operator()(AccRef acc, const pg8::Unit& u, int wr, int wc, int fr, int fq) const {
        const int row0 = u.pm * 256 + wr * 64 + fr;
        const int col0 = u.pn * 256 + wc * 32 + 8 * fq;
        const float* gp = gate + (size_t)(u.pm >> 5) * 3072 + col0;
        const float* sp = scale1 + (size_t)(u.pm >> 5) * 3072 + col0;
        float sq[8];
#pragma unroll
        for (int i = 0; i < 8; ++i) sq[i] = 0.f;
#pragma unroll
        for (int bj = 0; bj < 2; ++bj) {
            const f32x4 gv0 = *(const f32x4*)(gp + bj * 128), gv1 = *(const f32x4*)(gp + bj * 128 + 4);
            const f32x4 av0 = *(const f32x4*)(g1 + col0 + bj * 128) * (*(const f32x4*)(sp + bj * 128) + 1.f), av1 = *(const f32x4*)(g1 + col0 + bj * 128 + 4) * (*(const f32x4*)(sp + bj * 128 + 4) + 1.f);
#pragma unroll
            for (int ai = 0; ai < 2; ++ai)
#pragma unroll
                for (int m = 0; m < 4; ++m) {
                    const size_t off = (size_t)(row0 + ai * 128 + m * 16) * 1024 + col0 + bj * 128;
                    const f32x4 x0 = *(const f32x4*)(xin + off) + gv0 * acc[ai][bj][m][0], x1 = *(const f32x4*)(xin + off + 4) + gv1 * acc[ai][bj][m][1];
                    *(f32x4*)(xout + off) = x0; *(f32x4*)(xout + off + 4) = x1;
                    sq[ai * 4 + m] += ((x0[0] * x0[0] + x0[1] * x0[1]) + (x0[2] * x0[2] + x0[3] * x0[3])) + ((x1[0] * x1[0] + x1[1] * x1[1]) + (x1[2] * x1[2] + x1[3] * x1[3]));
                    const f32x4 h0 = x0 * av0, h1 = x1 * av1;
                    u32x4 w; w.x = pkbf(h0[0], h0[1]); w.y = pkbf(h0[2], h0[3]); w.z = pkbf(h1[0], h1[1]); w.w = pkbf(h1[2], h1[3]);
                    *(u32x4*)(H + off) = w;
                }
        }
#pragma unroll
        for (int i = 0; i < 8; ++i) {
            float t = sq[i]; t += __shfl_xor(t, 16); t += __shfl_xor(t, 32);
            if (fq == 0) red[wc * 256 + (i >> 2) * 128 + wr * 64 + (i & 3) * 16 + fr] = t;
        }
        asm volatile("s_waitcnt lgkmcnt(0)" ::: "memory"); __builtin_amdgcn_s_barrier(); asm volatile("" ::: "memory");
        { const int tl = threadIdx.x; if (tl < 256) ssq1[(size_t)(u.pm * 256 + tl) * 4 + u.pn] = (red[tl] + red[256 + tl]) + (red[512 + tl] + red[768 + tl]); }
        asm volatile("s_waitcnt lgkmcnt(0)" ::: "memory");
    }
};

DI unsigned f2bf(float f) { unsigned u = __builtin_bit_cast(unsigned, f); return (u + 0x7fffu + ((u >> 16) & 1u)) >> 16; }
DI unsigned pk2(float lo, float hi) { return f2bf(lo) | (f2bf(hi) << 16); }
DI void p0_transpose_item(const float* W, int K, int N, bf16_t* WT, LAS float* scr, int item, int lane) {
    const int nblk = N / 32, kb = item / nblk, nb = item % nblk, k0 = 64 * kb, n0 = 32 * nb;
#pragma unroll 8
    for (int i = 0; i < 32; ++i) { const int kk = 2 * i + (lane >> 5); scr[kk * 33 + (lane & 31)] = W[(size_t)(k0 + kk) * N + n0 + (lane & 31)]; }
    asm volatile("s_waitcnt lgkmcnt(0)" ::: "memory");
    const int c = lane & 7;
#pragma unroll
    for (int j = 0; j < 4; ++j) { const int n = (lane >> 3) + 8 * j; const LAS float* s = scr + (8 * c) * 33 + n;
        u32x4 o; o.x = pk2(s[0 * 33], s[1 * 33]); o.y = pk2(s[2 * 33], s[3 * 33]); o.z = pk2(s[4 * 33], s[5 * 33]); o.w = pk2(s[6 * 33], s[7 * 33]);
        *(u32x4*)(WT + (size_t)(n0 + n) * K + k0 + 8 * c) = o; }
    asm volatile("s_waitcnt lgkmcnt(0)" ::: "memory");
}

DI void p0_phase(LAS unsigned char* lds, const float* cvec, const float* ada_w, const float* ada_b, const float* w0in, const float* w0out, const float* w1in, const float* w1out,
                 unsigned char* ws, int bid, int G) {
    const int tid = threadIdx.x, lane = tid & 63, w = __builtin_amdgcn_readfirstlane(tid >> 6);
    float* mod = (float*)(ws + WS_MOD);
    if (bid == G - 1 && tid < 128) { float* invf = (float*)(ws + WS_INVF); invf[tid] = 1.0f / powf(10000.0f, (float)(2 * tid) / 256.0f); }
    LAS float* cond = (LAS float*)lds;
    LAS float* red = (LAS float*)(lds + 32768);
    if (bid < 96) {
        for (int i = tid; i < 8192; i += 512) { const float v = cvec[i]; cond[i] = v / (1.f + expf(-v)); }
        __syncthreads();
    }
    for (int mi = bid; mi < 96; mi += G) {
        const int n0 = mi * 64, layer = n0 / 3072, nn = n0 % 3072 + lane;
        const float* wp = ada_w + (size_t)layer * 1024 * 3072 + nn;
        float acc[8];
#pragma unroll
        for (int b = 0; b < 8; ++b) acc[b] = 0.f;
#pragma unroll 8
        for (int kk = 0; kk < 128; ++kk) { const int k = w * 128 + kk; const float wv = wp[(size_t)k * 3072];
#pragma unroll
            for (int b = 0; b < 8; ++b) acc[b] += cond[b * 1024 + k] * wv; }
#pragma unroll
        for (int b = 0; b < 8; ++b) red[(w * 8 + b) * 64 + lane] = acc[b];
        __syncthreads();
        { const int b = tid >> 6; float s = 0.f;
#pragma unroll
          for (int ww = 0; ww < 8; ++ww) s += red[(ww * 8 + b) * 64 + lane];
          mod[((size_t)layer * 8 + b) * 3072 + nn] = s + ada_b[layer * 3072 + nn]; }
        __syncthreads();
    }
    __syncthreads();
    LAS float* scr = (LAS float*)(lds + 65536 + w * 8704);
    const int gw = bid * 8 + w, NGW = G * 8;
    constexpr int I0 = (1024 / 64) * (6144 / 32), I1 = (2048 / 64) * (1024 / 32), I2 = (1024 / 64) * (8192 / 32), I3 = I1;
    for (int it = gw; it < I0 + I1 + I2 + I3; it += NGW) {
        int r = it;
        if (r < I0) { p0_transpose_item(w0in, 1024, 6144, (bf16_t*)(ws + WS_W0IN), scr, r, lane); continue; } r -= I0;
        if (r < I1) { p0_transpose_item(w0out, 2048, 1024, (bf16_t*)(ws + WS_W0OUT), scr, r, lane); continue; } r -= I1;
        if (r < I2) { p0_transpose_item(w1in, 1024, 8192, (bf16_t*)(ws + WS_W1IN), scr, r, lane); continue; } r -= I2;
        p0_transpose_item(w1out, 2048, 1024, (bf16_t*)(ws + WS_W1OUT), scr, r, lane);
    }
}

DI void sw_items(LAS unsigned char* lds, const float* modl, const float* W, int N, float* sw, int bid, int G) {
    const int tid = threadIdx.x, lane = tid & 63, w = __builtin_amdgcn_readfirstlane(tid >> 6);
    LAS float* vec = (LAS float*)lds;
    LAS float* red = (LAS float*)(lds + 32768);
    const int nitems = N / 64;
    if (bid < nitems) {
        for (int i = tid; i < 8192; i += 512) vec[i] = modl[(size_t)(i >> 10) * 3072 + (i & 1023)];
        __syncthreads();
    }
    for (int mi = bid; mi < nitems; mi += G) {
        const int n = mi * 64 + lane;
        const float* wp = W + n;
        float acc[8];
#pragma unroll
        for (int b = 0; b < 8; ++b) acc[b] = 0.f;
#pragma unroll 8
        for (int kk = 0; kk < 128; ++kk) { const int k = w * 128 + kk; const float wv = wp[(size_t)k * N];
#pragma unroll
            for (int b = 0; b < 8; ++b) acc[b] += vec[b * 1024 + k] * wv; }
#pragma unroll
        for (int b = 0; b < 8; ++b) red[(w * 8 + b) * 64 + lane] = acc[b];
        __syncthreads();
        { const int b = tid >> 6; float sm = 0.f;
#pragma unroll
          for (int ww = 0; ww < 8; ++ww) sm += red[(ww * 8 + b) * 64 + lane];
          sw[(size_t)b * N + n] = sm; }
        __syncthreads();
    }
    __syncthreads();
}

DI void ln_phase(const float* xin, bf16_t* h, const float* ng, const float* modl, int gw, int NGW, int lane) {
    for (int m = gw; m < NTOK; m += NGW) {
        const int b = m >> 13;
        const float* xr = xin + (size_t)m * 1024;
        const float* sh = modl + (size_t)b * 3072; const float* scl = sh + 1024;
        f32x4 v[4];
        v[0] = *(const f32x4*)(xr + 8 * lane); v[1] = *(const f32x4*)(xr + 8 * lane + 4); v[2] = *(const f32x4*)(xr + 512 + 8 * lane); v[3] = *(const f32x4*)(xr + 512 + 8 * lane + 4);
        float ss = 0.f;
#pragma unroll
        for (int i = 0; i < 4; ++i) ss += (v[i][0] * v[i][0] + v[i][1] * v[i][1]) + (v[i][2] * v[i][2] + v[i][3] * v[i][3]);
        ss = wave_sum(ss);
        const float rstd = 1.0f / sqrtf(ss * (1.f / 1024.f) + EPSF);
        float o[16];
#pragma unroll
        for (int i = 0; i < 4; ++i) { const int c = (i >> 1) * 512 + 8 * lane + (i & 1) * 4;
            const f32x4 g = *(const f32x4*)(ng + c), s1 = *(const f32x4*)(scl + c), s0 = *(const f32x4*)(sh + c);
#pragma unroll
            for (int e = 0; e < 4; ++e) o[4 * i + e] = v[i][e] * rstd * g[e] * (1.f + s1[e]) + s0[e]; }
        u32x4 w0, w1;
        w0.x = pkbf(o[0], o[1]); w0.y = pkbf(o[2], o[3]); w0.z = pkbf(o[4], o[5]); w0.w = pkbf(o[6], o[7]);
        w1.x = pkbf(o[8], o[9]); w1.y = pkbf(o[10], o[11]); w1.z = pkbf(o[12], o[13]); w1.w = pkbf(o[14], o[15]);
        *(u32x4*)(h + (size_t)m * 1024 + 8 * lane) = w0; *(u32x4*)(h + (size_t)m * 1024 + 512 + 8 * lane) = w1;
    }
}

constexpr int R_QSTR = 528, R_KSTR = 544, R_VSTR = 160, R_PSTR = 144;
constexpr int R_QL = 0, R_KL = R_QL + 64 * R_QSTR, R_VL = R_KL + 64 * R_KSTR, R_PL = R_VL + 64 * R_VSTR, R_XL = R_PL + 64 * R_PSTR, R_SL = R_XL + 16384, R_END = R_SL + 4096;
static_assert(R_END <= LDS_BYTES, "retention LDS");

template <int KH> DI void ret_rd16(s16x4 (&qb)[16], unsigned own_addr, unsigned oth_addr) {
    asm volatile("ds_read_b64 %0, %16 offset:%18\n\t"
                        "ds_read_b64 %1, %16 offset:%19\n\t"
                        "ds_read_b64 %2, %17 offset:%18\n\t"
                        "ds_read_b64 %3, %17 offset:%19\n\t"
                        "ds_read_b64 %4, %16 offset:%20\n\t"
                        "ds_read_b64 %5, %16 offset:%21\n\t"
                        "ds_read_b64 %6, %17 offset:%20\n\t"
                        "ds_read_b64 %7, %17 offset:%21\n\t"
                        "ds_read_b64 %8, %16 offset:%22\n\t"
                        "ds_read_b64 %9, %16 offset:%23\n\t"
                        "ds_read_b64 %10, %17 offset:%22\n\t"
                        "ds_read_b64 %11, %17 offset:%23\n\t"
                        "ds_read_b64 %12, %16 offset:%24\n\t"
                        "ds_read_b64 %13, %16 offset:%25\n\t"
                        "ds_read_b64 %14, %17 offset:%24\n\t"
                        "ds_read_b64 %15, %17 offset:%25"
                 : "=&v"(qb[0]), "=&v"(qb[1]), "=&v"(qb[2]), "=&v"(qb[3]), "=&v"(qb[4]), "=&v"(qb[5]), "=&v"(qb[6]), "=&v"(qb[7]), "=&v"(qb[8]), "=&v"(qb[9]), "=&v"(qb[10]), "=&v"(qb[11]), "=&v"(qb[12]), "=&v"(qb[13]), "=&v"(qb[14]), "=&v"(qb[15])
                 : "v"(own_addr), "v"(oth_addr), "n"(0 * 16 * R_QSTR + (2 * KH + 0) * 64 + 0 * 32), "n"(0 * 16 * R_QSTR + (2 * KH + 0) * 64 + 1 * 32), "n"(1 * 16 * R_QSTR + (2 * KH + 0) * 64 + 0 * 32), "n"(1 * 16 * R_QSTR + (2 * KH + 0) * 64 + 1 * 32), "n"(0 * 16 * R_QSTR + (2 * KH + 1) * 64 + 0 * 32), "n"(0 * 16 * R_QSTR + (2 * KH + 1) * 64 + 1 * 32), "n"(1 * 16 * R_QSTR + (2 * KH + 1) * 64 + 0 * 32), "n"(1 * 16 * R_QSTR + (2 * KH + 1) * 64 + 1 * 32)
                 : "memory");
}

DI void ret_wait16(s16x4 (&qb)[16]) {
    asm volatile("s_waitcnt lgkmcnt(0)" : "+v"(qb[0]), "+v"(qb[1]), "+v"(qb[2]), "+v"(qb[3]), "+v"(qb[4]), "+v"(qb[5]), "+v"(qb[6]), "+v"(qb[7]) :: "memory");
    asm volatile("" : "+v"(qb[8]), "+v"(qb[9]), "+v"(qb[10]), "+v"(qb[11]), "+v"(qb[12]), "+v"(qb[13]), "+v"(qb[14]), "+v"(qb[15]) :: "memory");
}

template <int SH> DI void ret_phase(LAS unsigned char* lds, const bf16_t* Q0, const bf16_t* K0, bf16_t* V0, float* ssq, int vcu, int G, int magic) {
    const int tid = threadIdx.x, lane = tid & 63, w = __builtin_amdgcn_readfirstlane(tid >> 6), fr = lane & 15, fq = lane >> 4;
    const int et = w & 3, dh = w >> 2;
    for (int it = vcu; it < 256; it += G) {
        const int bh = it >> 3, dvt = it & 7, b = bh >> 2, h = bh & 3;
        const float lg2 = log2f(1.0f - exp2f(-5.0f - (float)h));
        const float cd = exp2f(lg2 * 64.f);
        float kd[2][8];
#pragma unroll
        for (int s = 0; s < 2; ++s)
#pragma unroll
            for (int jj = 0; jj < 8; ++jj) kd[s][jj] = exp2f(lg2 * (float)(63 - (32 * s + 16 * (jj >> 2) + 4 * fq + (jj & 3))));
        const int ct_own = 2 * dh, ct_oth = 2 * (1 - dh);
        float qd[2];
#pragma unroll
        for (int i = 0; i < 2; ++i) qd[i] = exp2f(lg2 * (float)(16 * (ct_own + i) + fr + 1));
        f32x4 st[8];
#pragma unroll
        for (int t = 0; t < 8; ++t) st[t] = (f32x4){0.f, 0.f, 0.f, 0.f};
        const size_t tok0 = (size_t)b * SEQ;
        u32x4 qr[4], kr[4], vr;
#define R_ISSUE(j) do { _Pragma("unroll") for (int i_ = 0; i_ < 4; ++i_) { const int ch_ = tid + 512 * i_; const size_t g_ = (tok0 + (size_t)(j) * 64 + (ch_ >> 5)) * 1024 + h * 256 + (ch_ & 31) * 8; \
            qr[i_] = *(const u32x4*)(Q0 + g_); kr[i_] = *(const u32x4*)(K0 + g_); } \
            vr = *(const u32x4*)(V0 + (tok0 + (size_t)(j) * 64 + (tid >> 3)) * 2048 + h * 512 + dvt * 64 + (tid & 7) * 8); } while (0)
#define R_WRITE() do { _Pragma("unroll") for (int i_ = 0; i_ < 4; ++i_) { const int ch_ = tid + 512 * i_; \
            *(LAS u32x4*)(lds + R_QL + (ch_ >> 5) * R_QSTR + (ch_ & 31) * 16) = qr[i_]; *(LAS u32x4*)(lds + R_KL + (ch_ >> 5) * R_KSTR + (ch_ & 31) * 16) = kr[i_]; } \
            *(LAS u32x4*)(lds + R_VL + (tid >> 3) * R_VSTR + (tid & 7) * 16) = vr; } while (0)
        R_ISSUE(0); R_WRITE(); LDS_BARRIER();
        for (int j = 0; j < 128; ++j) {
            if (SH != 1 && j + 1 < 128) R_ISSUE(j + 1);
            if (SH == 0 && j > 0 && tid < 64) { const LAS float* sl = (const LAS float*)(lds + R_SL) + tid; float sa = 0.f;
#pragma unroll
                for (int u = 0; u < 16; ++u) sa += sl[u * 64];
                ssq[((tok0 + (size_t)(j - 1) * 64 + tid) * 4 + h) * 8 + dvt] = sa; }
            const unsigned qo_a = (unsigned)(size_t)(lds + R_QL + (16 * ct_own + fr) * R_QSTR + (128 * dh + 4 * fq) * 2);
            const unsigned qt_a = (unsigned)(size_t)(lds + R_QL + (16 * ct_oth + fr) * R_QSTR + (128 * dh + 4 * fq) * 2);
            s16x4 qb[16];
            ret_rd16<0>(qb, qo_a, qt_a);
            {
                const int kt = w & 3, ctp = w >> 2;
                f32x4 sc0 = (f32x4){0.f, 0.f, 0.f, 0.f}, sc1 = sc0;
                const LAS unsigned char* kp = lds + R_KL + (16 * kt + fr) * R_KSTR + fq * 16;
                const LAS unsigned char* qp = lds + R_QL + (32 * ctp + fr) * R_QSTR + fq * 16;
#pragma unroll
                for (int ks = 0; ks < 8; ++ks) {
                    const bf16x8 kf = *(const LAS bf16x8*)(kp + ks * 64), q0 = *(const LAS bf16x8*)(qp + ks * 64), q1 = *(const LAS bf16x8*)(qp + 16 * R_QSTR + ks * 64);
                    sc0 = mfma16(kf, q0, sc0); sc1 = mfma16(kf, q1, sc1);
                }
                const int c0 = 32 * ctp + fr, kbase = 16 * kt + 4 * fq;
                float p0[4], p1[4];
#pragma unroll
                for (int r = 0; r < 4; ++r) { const int d0 = c0 - (kbase + r), d1 = d0 + 16;
                    p0[r] = sc0[r] * ex2(lg2 * (float)(d0 < 0 ? -d0 : d0)); p1[r] = sc1[r] * ex2(lg2 * (float)(d1 < 0 ? -d1 : d1)); }
                u32x2 w0, w1; w0.x = pkbf(p0[0], p0[1]); w0.y = pkbf(p0[2], p0[3]); w1.x = pkbf(p1[0], p1[1]); w1.y = pkbf(p1[2], p1[3]);
                *(LAS u32x2*)(lds + R_PL + c0 * R_PSTR + kbase * 2) = w0; *(LAS u32x2*)(lds + R_PL + (c0 + 16) * R_PSTR + kbase * 2) = w1;
            }
            f32x4 own[2], oth[2];
#pragma unroll
            for (int i = 0; i < 2; ++i) { own[i] = (f32x4){0.f, 0.f, 0.f, 0.f}; oth[i] = own[i]; }
            {
                ret_wait16(qb);
#pragma unroll
                for (int kk = 0; kk < 2; ++kk) {
                    const bf16x8 a = pack8(st[2 * kk], st[2 * kk + 1]);
#pragma unroll
                    for (int i = 0; i < 2; ++i) { own[i] = mfma16(a, cat4(qb[kk * 8 + i * 4], qb[kk * 8 + i * 4 + 1]), own[i]); oth[i] = mfma16(a, cat4(qb[kk * 8 + i * 4 + 2], qb[kk * 8 + i * 4 + 3]), oth[i]); }
                }
                ret_rd16<1>(qb, qo_a, qt_a);
                ret_wait16(qb);
#pragma unroll
                for (int kk = 0; kk < 2; ++kk) {
                    const bf16x8 a = pack8(st[4 + 2 * kk], st[4 + 2 * kk + 1]);
#pragma unroll
                    for (int i = 0; i < 2; ++i) { own[i] = mfma16(a, cat4(qb[kk * 8 + i * 4], qb[kk * 8 + i * 4 + 1]), own[i]); oth[i] = mfma16(a, cat4(qb[kk * 8 + i * 4 + 2], qb[kk * 8 + i * 4 + 3]), oth[i]); }
                }
#pragma unroll
                for (int i = 0; i < 2; ++i) *(LAS f32x4*)(lds + R_XL + ((w * 2 + i) * 64 + lane) * 16) = oth[i];
            }
            bf16x8 vf[2];
#pragma unroll
            for (int s = 0; s < 2; ++s) {
                const LAS unsigned char* va = lds + R_VL + (32 * s + 4 * fq + (fr >> 2)) * R_VSTR + (16 * et + 4 * (fr & 3)) * 2;
                vf[s] = cat4(tr_read(va), tr_read(va + 16 * R_VSTR));
            }
#pragma unroll
            for (int t = 0; t < 8; ++t) st[t] = st[t] * cd;
#pragma unroll
            for (int s = 0; s < 2; ++s) {
                const u32x4 vu = __builtin_bit_cast(u32x4, vf[s]); u32x4 vsu;
#pragma unroll
                for (int e = 0; e < 4; ++e) vsu[e] = pkbf(bflo(vu[e]) * kd[s][2 * e], bfhi(vu[e]) * kd[s][2 * e + 1]);
                const bf16x8 vs = __builtin_bit_cast(bf16x8, vsu);
                const LAS unsigned char* ka = lds + R_KL + (32 * s + 4 * fq + (fr >> 2)) * R_KSTR + (128 * dh + 4 * (fr & 3)) * 2;
#pragma unroll
                for (int t = 0; t < 8; ++t) st[t] = mfma16(cat4(tr_read(ka + t * 32), tr_read(ka + t * 32 + 16 * R_KSTR)), vs, st[t]);
            }
            LDS_BARRIER();
            {
                const int pw = et + 4 * (1 - dh);
#pragma unroll
                for (int i = 0; i < 2; ++i) { const f32x4 o2 = *(const LAS f32x4*)(lds + R_XL + ((pw * 2 + i) * 64 + lane) * 16); own[i] = (own[i] + o2) * qd[i]; }
            }
#pragma unroll
            for (int s = 0; s < 2; ++s)
#pragma unroll
                for (int i = 0; i < 2; ++i) { const LAS unsigned char* pa = lds + R_PL + (16 * (ct_own + i) + fr) * R_PSTR + (32 * s + 4 * fq) * 2;
                    own[i] = mfma16(vf[s], cat4(*(const LAS s16x4*)pa, *(const LAS s16x4*)(pa + 32)), own[i]); }
            if (j + 1 < 128) R_WRITE();
#pragma unroll
            for (int i = 0; i < 2; ++i) {
                const int c = 16 * (ct_own + i) + fr;
                u32x2 ow; ow.x = pkbf(own[i][0], own[i][1]); ow.y = pkbf(own[i][2], own[i][3]);
                const float sq = (own[i][0] * own[i][0] + own[i][1] * own[i][1]) + (own[i][2] * own[i][2] + own[i][3] * own[i][3]);
                if (SH == 0 || sq == (float)magic) *(u32x2*)(V0 + (tok0 + (size_t)j * 64 + c) * 2048 + h * 512 + dvt * 64 + 16 * et + 4 * fq) = ow;
                *(LAS float*)(lds + R_SL + ((et * 4 + fq) * 64 + c) * 4) = sq;
            }
            LDS_BARRIER();
        }
        if (SH == 0 && tid < 64) { const LAS float* sl = (const LAS float*)(lds + R_SL) + tid; float sa = 0.f;
#pragma unroll
            for (int u = 0; u < 16; ++u) sa += sl[u * 64];
            ssq[((tok0 + (size_t)127 * 64 + tid) * 4 + h) * 8 + dvt] = sa; }
        LDS_BARRIER();
#undef R_ISSUE
#undef R_WRITE
    }
}

constexpr int A_KSTR = 288, A_VSTR = 288, A_KT = 64 * A_KSTR, A_VT = 64 * A_VSTR, A_BUF = A_KT + A_VT, A_TAB = 2 * A_BUF, A_END = A_TAB + 1280;
static_assert(A_END <= LDS_BYTES, "attention LDS");
constexpr float LOG2E = 1.4426950408889634f;

template <int SH> DI void att_phase(LAS unsigned char* lds, bf16_t* Q1, const bf16_t* K1, const bf16_t* V1, const float* qg, const float* kg, const float* rel, int vcu, int G, int magic) {
    const int tid = threadIdx.x, lane = tid & 63, w = __builtin_amdgcn_readfirstlane(tid >> 6), fr = lane & 15, fq = lane >> 4;
    const int lrow = tid >> 4, lcc = tid & 15;
    float kgv[8];
#pragma unroll
    for (int e = 0; e < 8; ++e) kgv[e] = kg[lcc * 8 + e];
    LAS float* tab = (LAS float*)(lds + A_TAB);
    float gmx;
    { float a = fmaxf(fabsf(qg[lane]), fabsf(qg[lane + 64])), c = fmaxf(fabsf(kg[lane]), fabsf(kg[lane + 64]));
#pragma unroll
      for (int o = 1; o < 64; o <<= 1) { a = fmaxf(a, __shfl_xor(a, o)); c = fmaxf(c, __shfl_xor(c, o)); }
      gmx = 11.313708498984761f * a * c * LOG2E; }
    for (int it = vcu; it < 4096; it += G) {
        const int b = it >> 9, h = (it >> 5) & 15, jg = it & 31;
        const int jw = 4 * jg + (w >> 1), qoff = (w & 1) * 32;
        const size_t qrow0 = (size_t)b * SEQ + (size_t)jw * 64 + qoff;
        const int rot = (8 * jg) % 12, nst = 12;
#define A_KC(t) (4 * jg - 8 + (((t) + rot) % 12))
        u32x4 kr0, kr1, vr0, vr1;
#define A_ISSUE(kc) do { const int kc_ = (kc) < 0 ? 0 : (kc); const size_t g_ = ((size_t)b * SEQ + (size_t)kc_ * 64 + lrow) * 2048 + h * 128 + lcc * 8; \
            kr0 = *(const u32x4*)(K1 + g_); kr1 = *(const u32x4*)(K1 + g_ + 32 * 2048); vr0 = *(const u32x4*)(V1 + g_); vr1 = *(const u32x4*)(V1 + g_ + 32 * 2048); } while (0)
#define A_WRITE(buf) do { float s0_ = ssq8(kr0), s1_ = ssq8(kr1); \
            s0_ = row16_sum(s0_); s1_ = row16_sum(s1_); \
            const float r0_ = __builtin_amdgcn_rsqf(s0_ * (1.f / 128.f) + EPSF), r1_ = __builtin_amdgcn_rsqf(s1_ * (1.f / 128.f) + EPSF); \
            u32x4 k0_, k1_; \
            _Pragma("unroll") for (int e_ = 0; e_ < 4; ++e_) { k0_[e_] = pkbf(bflo(kr0[e_]) * r0_ * kgv[2 * e_], bfhi(kr0[e_]) * r0_ * kgv[2 * e_ + 1]); \
                k1_[e_] = pkbf(bflo(kr1[e_]) * r1_ * kgv[2 * e_], bfhi(kr1[e_]) * r1_ * kgv[2 * e_ + 1]); } \
            LAS unsigned char* bb_ = lds + (buf) * A_BUF; \
            *(LAS u32x4*)(bb_ + lrow * A_KSTR + lcc * 16) = k0_; *(LAS u32x4*)(bb_ + (lrow + 32) * A_KSTR + lcc * 16) = k1_; \
            *(LAS u32x4*)(bb_ + A_KT + lrow * A_VSTR + lcc * 16) = vr0; *(LAS u32x4*)(bb_ + A_KT + (lrow + 32) * A_VSTR + lcc * 16) = vr1; } while (0)
        A_ISSUE(A_KC(0));
        float bmx, bmn;
        { float v0 = rel[h * 257 + lane], v1 = rel[h * 257 + 64 + lane], v2 = rel[h * 257 + 128 + lane], v3 = rel[h * 257 + 192 + lane], v4 = rel[h * 257 + 256];
          bmx = fmaxf(fmaxf(fmaxf(v0, v1), fmaxf(v2, v3)), v4); bmn = fminf(fminf(fminf(v0, v1), fminf(v2, v3)), v4);
#pragma unroll
          for (int o = 1; o < 64; o <<= 1) { bmx = fmaxf(bmx, __shfl_xor(bmx, o)); bmn = fminf(bmn, __shfl_xor(bmn, o)); } }
        const float mfix = gmx + bmx * LOG2E;
        const bool fast = (2.f * gmx + (bmx - bmn) * LOG2E) <= 120.f;
        if (tid < 320) tab[tid] = rel[h * 257 + (tid < 256 ? tid : 256)] * LOG2E - mfix;
        bf16x8 Qf[2][4];
        {
            const float qsc = 0.08838834764831845f * LOG2E;
#pragma unroll
            for (int qt = 0; qt < 2; ++qt) {
                u32x4 raw[4]; float ss = 0.f;
                const bf16_t* qp = Q1 + (qrow0 + 16 * qt + fr) * 2048 + h * 128 + 8 * fq;
#pragma unroll
                for (int ks = 0; ks < 4; ++ks) { raw[ks] = *(const u32x4*)(qp + 32 * ks); ss += ssq8(raw[ks]); }
                ss += __shfl_xor(ss, 16); ss += __shfl_xor(ss, 32);
                const float rs = __builtin_amdgcn_rsqf(ss * (1.f / 128.f) + EPSF) * qsc;
#pragma unroll
                for (int ks = 0; ks < 4; ++ks) {
                    const f32x4 g0 = *(const f32x4*)(qg + 32 * ks + 8 * fq), g1 = *(const f32x4*)(qg + 32 * ks + 8 * fq + 4);
                    u32x4 pq;
                    pq.x = pkbf(bflo(raw[ks].x) * rs * g0[0], bfhi(raw[ks].x) * rs * g0[1]); pq.y = pkbf(bflo(raw[ks].y) * rs * g0[2], bfhi(raw[ks].y) * rs * g0[3]);
                    pq.z = pkbf(bflo(raw[ks].z) * rs * g1[0], bfhi(raw[ks].z) * rs * g1[1]); pq.w = pkbf(bflo(raw[ks].w) * rs * g1[2], bfhi(raw[ks].w) * rs * g1[3]);
                    Qf[qt][ks] = __builtin_bit_cast(bf16x8, pq);
                }
            }
        }
        f32x4 O[8][2];
#pragma unroll
        for (int nt = 0; nt < 8; ++nt) { O[nt][0] = (f32x4){0.f, 0.f, 0.f, 0.f}; O[nt][1] = O[nt][0]; }
        float mrun[2] = {-1e30f, -1e30f}, lsum[2] = {0.f, 0.f};
        A_WRITE(0);
        LDS_BARRIER();
        for (int t = 0; t < nst; ++t) {
            const int kc = A_KC(t);
            if (SH == 0 && t + 1 < nst) A_ISSUE(A_KC(t + 1));
            const int delta = jw - kc;
            if (kc >= 0 && delta >= 0 && delta <= 8) {
                const LAS unsigned char* kb = lds + (t & 1) * A_BUF;
                const LAS unsigned char* vb = kb + A_KT;
                f32x4 s[4][2];
                if (delta >= 3) { const float bc = tab[256];
#pragma unroll
                    for (int kt = 0; kt < 4; ++kt)
#pragma unroll
                        for (int qt = 0; qt < 2; ++qt) s[kt][qt] = (f32x4){bc, bc, bc, bc};
                } else {
                    const LAS float* tp = tab + (qoff + fr - 4 * fq + 128 - 51 + 64 * delta);
#pragma unroll
                    for (int kt = 0; kt < 4; ++kt)
#pragma unroll
                        for (int qt = 0; qt < 2; ++qt)
#pragma unroll
                            for (int r = 0; r < 4; ++r) s[kt][qt][r] = tp[16 * qt - 16 * kt - r + 51];
                }
#pragma unroll
                for (int kh = 0; kh < 2; ++kh) {
                    bf16x8 kf[2][4];
#pragma unroll
                    for (int kt = 0; kt < 2; ++kt)
#pragma unroll
                        for (int ks = 0; ks < 4; ++ks) kf[kt][ks] = *(const LAS bf16x8*)(kb + (16 * (2 * kh + kt) + fr) * A_KSTR + (32 * ks + 8 * fq) * 2);
#pragma unroll
                    for (int kt = 0; kt < 2; ++kt)
#pragma unroll
                        for (int qt = 0; qt < 2; ++qt) { f32x4 c = s[2 * kh + kt][qt];
#pragma unroll
                            for (int ks = 0; ks < 4; ++ks) c = mfma16(kf[kt][ks], Qf[qt][ks], c);
                            s[2 * kh + kt][qt] = c; }
                }
                if (SH == 3) { lsum[0] += s[0][0][0]; lsum[1] += s[0][1][0]; } else
                if (fast) {
#pragma unroll
                    for (int qt = 0; qt < 2; ++qt) { float ps = 0.f;
#pragma unroll
                        for (int kt = 0; kt < 4; ++kt)
#pragma unroll
                            for (int r = 0; r < 4; ++r) { const float p = ex2(s[kt][qt][r]); s[kt][qt][r] = p; ps += p; }
                        lsum[qt] += ps; }
                } else {
#pragma unroll
                    for (int qt = 0; qt < 2; ++qt) {
                        float mx = s[0][qt][0];
#pragma unroll
                        for (int kt = 0; kt < 4; ++kt)
#pragma unroll
                            for (int r = 0; r < 4; ++r) mx = fmaxf(mx, s[kt][qt][r]);
                        mx = fmaxf(mx, __shfl_xor(mx, 16)); mx = fmaxf(mx, __shfl_xor(mx, 32));
                        const float mn = fmaxf(mrun[qt], mx), alpha = ex2(mrun[qt] - mn); mrun[qt] = mn;
                        float ps = 0.f;
#pragma unroll
                        for (int kt = 0; kt < 4; ++kt)
#pragma unroll
                            for (int r = 0; r < 4; ++r) { const float p = ex2(s[kt][qt][r] - mn); s[kt][qt][r] = p; ps += p; }
                        lsum[qt] = lsum[qt] * alpha + ps;
#pragma unroll
                        for (int nt = 0; nt < 8; ++nt) O[nt][qt] = O[nt][qt] * alpha;
                    }
                }
#pragma unroll
                for (int s2 = 0; s2 < 2; ++s2) {
                    const bf16x8 pf0 = pack8(s[2 * s2][0], s[2 * s2 + 1][0]), pf1 = pack8(s[2 * s2][1], s[2 * s2 + 1][1]);
                    const LAS unsigned char* va = vb + (32 * s2 + 4 * fq + (fr >> 2)) * A_VSTR + 4 * (fr & 3) * 2;
#pragma unroll
                    for (int nt = 0; nt < 8; ++nt) {
                        const bf16x8 vfr = cat4(tr_read(va + nt * 32), tr_read(va + nt * 32 + 16 * A_VSTR));
                        O[nt][0] = mfma16(vfr, pf0, O[nt][0]); O[nt][1] = mfma16(vfr, pf1, O[nt][1]);
                    }
                }
            }
            if (SH < 2 && t + 1 < nst) A_WRITE((t + 1) & 1);
            if (SH != 4) LDS_BARRIER();
        }
#pragma unroll
        for (int qt = 0; qt < 2; ++qt) {
            float l = lsum[qt]; l += __shfl_xor(l, 16); l += __shfl_xor(l, 32);
            const float inv = 1.0f / l;
            if (SH == 0 || l == (float)magic)
            { bf16_t* op = Q1 + (qrow0 + 16 * qt + fr) * 2048 + h * 128 + 4 * fq;
#pragma unroll
            for (int nt = 0; nt < 8; ++nt) { u32x2 ow; ow.x = pkbf(O[nt][qt][0] * inv, O[nt][qt][1] * inv); ow.y = pkbf(O[nt][qt][2] * inv, O[nt][qt][3] * inv);
                *(u32x2*)(op + 16 * nt) = ow; } }
        }
#undef A_ISSUE
#undef A_KC
#undef A_WRITE
    }
}

struct Args { const float* x; const float* c; const int* pos; const float* norm_g; const float* ada_w; const float* ada_b; const float* ret_w_in; const float* ret_gn; const float* ret_w_out;
              const float* att_w_in; const float* att_qg; const float* att_kg; const float* att_rel; const float* att_w_out; float* out; unsigned char* ws; int ph_lo, ph_hi; };
constexpr int NPH = 11;

__global__ void __launch_bounds__(512, 2) mega_fwd(Args a) {
    extern __shared__ __attribute__((aligned(16))) unsigned char lds_raw[];
    __builtin_assume(__builtin_amdgcn_workitem_id_y() == 0); __builtin_assume(__builtin_amdgcn_workitem_id_z() == 0);
    LAS unsigned char* lds = (LAS unsigned char*)lds_raw;
    cg::grid_group grid = cg::this_grid();
    const int tid = threadIdx.x, lane = tid & 63, w = __builtin_amdgcn_readfirstlane(tid >> 6);
    const int G = gridDim.x, bid = blockIdx.x;
    const int vcu = (G % 8 == 0) ? (bid % 8) * (G / 8) + bid / 8 : bid;
    const int gw = bid * 8 + w, NGW = G * 8;
    unsigned char* ws = a.ws;
    bf16_t* H = (bf16_t*)(ws + WS_H);
    const float* mod = (const float*)(ws + WS_MOD);
    const int lo = a.ph_lo, hi = a.ph_hi;
#define IN(k) (lo <= (k) && (k) < hi)
#ifndef PROBE_MASK
#define PROBE_MASK 0
#endif
    unsigned long long t_prev = 0, t_acc = 0;
    if (PROBE_MASK) t_prev = __builtin_amdgcn_s_memrealtime();
#define SEAM(k) do { if (IN(k) && IN((k) + 1)) grid.sync(); if (PROBE_MASK) { const unsigned long long t_ = __builtin_amdgcn_s_memrealtime(); if ((PROBE_MASK >> (k)) & 1) t_acc += t_ - t_prev; t_prev = t_; } } while (0)
    if (IN(0)) p0_phase(lds, a.c, a.ada_w, a.ada_b, a.ret_w_in, a.ret_w_out, a.att_w_in, a.att_w_out, ws, bid, G);
    SEAM(0);
    if (IN(1)) { sw_items(lds, mod + 8 * 3072, a.att_w_in, 8192, (float*)(ws + WS_SW1), bid, G); ln_phase(a.x, H, a.norm_g, mod, gw, NGW, lane); }
    SEAM(1);
    if (IN(2)) {
        pg8::Gemm g{H, (const bf16_t*)(ws + WS_W0IN), NTOK, 4096, 1024}; pg8::StaticOrder S; S.init(NTOK, 4096, G, bid);
        EpiA0 E{(bf16_t*)(ws + WS_Q0), (bf16_t*)(ws + WS_K0), (bf16_t*)(ws + WS_V0), a.pos, (const float*)(ws + WS_INVF)};
        pg8::gemm_phase<EpiA0, pg8::StaticOrder, true, true>(lds, g, S, E);
    }
    SEAM(2);
    if (IN(3)) { ret_phase<0>(lds, (const bf16_t*)(ws + WS_Q0), (const bf16_t*)(ws + WS_K0), (bf16_t*)(ws + WS_V0), (float*)(ws + WS_SSQ), vcu, G, lo - 1);
        if (PROBE_SHADOW >= 10) ret_phase<PROBE_SHADOW - 9>(lds, (const bf16_t*)(ws + WS_Q0), (const bf16_t*)(ws + WS_K0), (bf16_t*)(ws + WS_V0), (float*)(ws + WS_SSQ), vcu, G, lo - 1); }
    SEAM(3);
    if (IN(4)) {
        pg8::Gemm g{H, (const bf16_t*)(ws + WS_W0IN) + (size_t)4096 * 1024, NTOK, 2048, 1024}; pg8::StaticOrder S; S.init(NTOK, 2048, G, bid);
        EpiG<0> E{(bf16_t*)(ws + WS_V0), (const float*)(ws + WS_SSQ), a.ret_gn, nullptr};
        pg8::gemm_phase<EpiG<0>, pg8::StaticOrder, true, true>(lds, g, S, E);
    }
    SEAM(4);
    if (IN(5)) {
        pg8::Gemm g{(const bf16_t*)(ws + WS_V0), (const bf16_t*)(ws + WS_W0OUT), NTOK, 1024, 2048}; pg8::StaticOrder S; S.init(NTOK, 1024, G, bid);
        EpiOutLN E{a.x, a.out, mod + 2048, H, a.norm_g + 1024, mod + 8 * 3072 + 1024, (float*)(ws + WS_SSQ), (LAS float*)(lds + 131072)};
        pg8::gemm_phase<EpiOutLN, pg8::StaticOrder, true, true>(lds, g, S, E);
    }
    SEAM(5);
    if (IN(7)) {
        pg8::Gemm g{H, (const bf16_t*)(ws + WS_W1IN), NTOK, 6144, 1024}; pg8::StaticOrder S; S.init(NTOK, 6144, G, bid);
        EpiA1 E{(bf16_t*)(ws + WS_Q1), (const float*)(ws + WS_SSQ), (const float*)(ws + WS_SW1)};
        pg8::gemm_phase<EpiA1, pg8::StaticOrder, true, true>(lds, g, S, E);
    }
    SEAM(7);
    if (IN(8)) { att_phase<0>(lds, (bf16_t*)(ws + WS_Q1), (const bf16_t*)(ws + WS_K1), (const bf16_t*)(ws + WS_V1), a.att_qg, a.att_kg, a.att_rel, vcu, G, lo - 1);
        if (PROBE_SHADOW >= 1 && PROBE_SHADOW < 10) att_phase<(PROBE_SHADOW < 10 ? PROBE_SHADOW : 1)>(lds, (bf16_t*)(ws + WS_Q1), (const bf16_t*)(ws + WS_K1), (const bf16_t*)(ws + WS_V1), a.att_qg, a.att_kg, a.att_rel, vcu, G, lo - 1); }
    SEAM(8);
    if (IN(9)) {
        pg8::Gemm g{H, (const bf16_t*)(ws + WS_W1IN) + (size_t)6144 * 1024, NTOK, 2048, 1024}; pg8::StaticOrder S; S.init(NTOK, 2048, G, bid);
        EpiG<1> E{(bf16_t*)(ws + WS_Q1), (const float*)(ws + WS_SSQ), nullptr, (const float*)(ws + WS_SW1)};
        pg8::gemm_phase<EpiG<1>, pg8::StaticOrder, true, true>(lds, g, S, E);
    }
    SEAM(9);
    if (IN(10)) {
        pg8::Gemm g{(const bf16_t*)(ws + WS_Q1), (const bf16_t*)(ws + WS_W1OUT), NTOK, 1024, 2048}; pg8::StaticOrder S; S.init(NTOK, 1024, G, bid);
        EpiOut E{a.out, a.out, mod + 8 * 3072 + 2048};
        pg8::gemm_phase<EpiOut, pg8::StaticOrder, true, true>(lds, g, S, E);
    }
    if (PROBE_MASK) { const unsigned long long t_ = __builtin_amdgcn_s_memrealtime(); if ((PROBE_MASK >> 10) & 1) t_acc += t_ - t_prev;
        if (bid == 0 && tid == 0) { while (__builtin_amdgcn_s_memrealtime() - t_ < t_acc) __builtin_amdgcn_s_sleep(8); } }
#undef IN
#undef SEAM
}

extern "C" void kernel_launch(void* const* d_in, const int* in_sizes, int n_in, void* d_out, int out_size, void* d_ws, size_t ws_size, hipStream_t stream) {
    static int grid = 0;
    if (grid == 0) {
        if (n_in != 14 || out_size != NTOK * DM || ws_size < WS_END) { fprintf(stderr, "kernel_launch: unexpected shapes (n_in %d out %d ws %zu need %zu)\n", n_in, out_size, ws_size, (size_t)WS_END); grid = -1; return; }
        int dev = 0, cus = 0, per_cu = 0;
        hipGetDevice(&dev);
        hipDeviceGetAttribute(&cus, hipDeviceAttributeMultiprocessorCount, dev);
        if (hipFuncSetAttribute((const void*)mega_fwd, hipFuncAttributeMaxDynamicSharedMemorySize, LDS_BYTES) != hipSuccess) { fprintf(stderr, "kernel_launch: hipFuncSetAttribute failed\n"); grid = -1; return; }
        if (hipOccupancyMaxActiveBlocksPerMultiprocessor(&per_cu, (const void*)mega_fwd, 512, LDS_BYTES) != hipSuccess || per_cu < 1) { fprintf(stderr, "kernel_launch: occupancy query says %d\n", per_cu); per_cu = 1; }
        (void)hipGetLastError();
        grid = cus * per_cu;
    }
    if (grid < 0) return;
    Args a{};
    a.x = (const float*)d_in[0]; a.c = (const float*)d_in[1]; a.pos = (const int*)d_in[2]; a.norm_g = (const float*)d_in[3]; a.ada_w = (const float*)d_in[4]; a.ada_b = (const float*)d_in[5];
    a.ret_w_in = (const float*)d_in[6]; a.ret_gn = (const float*)d_in[7]; a.ret_w_out = (const float*)d_in[8]; a.att_w_in = (const float*)d_in[9]; a.att_qg = (const float*)d_in[10];
    a.att_kg = (const float*)d_in[11]; a.att_rel = (const float*)d_in[12]; a.att_w_out = (const float*)d_in[13]; a.out = (float*)d_out; a.ws = (unsigned char*)d_ws;
#if MK_N_LAUNCHES == 1
    a.ph_lo = 0; a.ph_hi = NPH;
    void* args[] = {&a};
    hipError_t e = hipLaunchCooperativeKernel((const void*)mega_fwd, dim3(grid), dim3(512), args, LDS_BYTES, stream);
    if (e != hipSuccess) fprintf(stderr, "kernel_launch: cooperative launch failed: %s (grid %d)\n", hipGetErrorString(e), grid);
#else
    for (int p = 0; p < NPH; ++p) { a.ph_lo = p; a.ph_hi = p + 1; hipLaunchKernelGGL(mega_fwd, dim3(grid), dim3(512), LDS_BYTES, stream, a); }
#endif
}
```

```cpp
#include <hip/hip_runtime.h>
#include <hip/hip_cooperative_groups.h>
#include <cstdio>
#include <cstdint>
namespace cg = cooperative_groups;

#ifndef MK_N_LAUNCHES
#define MK_N_LAUNCHES 1
#endif
#ifndef PROBE_MASK
#define PROBE_MASK 0
#endif
#define PROBE_SHADOW 0

namespace pg8 {
#define PG8_LAS __attribute__((address_space(3)))
typedef unsigned short bf16_t;
typedef short bf16x8 __attribute__((ext_vector_type(8)));
typedef float f32x4 __attribute__((ext_vector_type(4)));
typedef unsigned u32x4 __attribute__((ext_vector_type(4)));
constexpr int BM = 256, BK = 64, HALF = 128, HTB = HALF * BK * 2  , STAGE_BYTES = 8 * HTB, NXCD = 8, WGM = 8;

__host__ __device__ __forceinline__ int lds_byte(int r, int c) { const int st = (r >> 4) * 2 + (c >> 5), rr = r & 15, cc = c & 31, ob = rr * 64 + cc * 2; return st * 1024 + (ob ^ (((ob >> 9) & 1) << 5)); }
__host__ __device__ __forceinline__ void stage_rc(int b, int& R, int& C) { const int st = b / 1024, sb = b % 1024, swz = sb ^ (((sb >> 9) & 1) << 5); R = (st >> 1) * 16 + swz / 64; C = (st & 1) * 32 + (swz % 64) / 2; }
__host__ __device__ __forceinline__ int perm32(int rho) { const int n = rho >> 4, i = rho & 15; return 8 * (i >> 2) + 4 * n + (i & 3); }

struct Unit { int pm, pn; };
struct Gemm { const bf16_t* A; const bf16_t* Bt; int M, N, K; };

struct StaticOrder {
    int nM, nN, nwg, G, c;
    __host__ __device__ void init(int M, int N, int G_, int c_) { nM = M / BM; nN = N / BM; nwg = nM * nN; G = G_; c = c_; }
    __host__ __device__ bool next(int i, Unit& u) const {
        const long L = (long)i * G + c; if (L >= nwg) return false;
        int wgid = (int)L; { const int q = nwg / NXCD, r = nwg % NXCD, xcd = wgid % NXCD, off = wgid / NXCD; wgid = (xcd < r ? xcd * (q + 1) : r * (q + 1) + (xcd - r) * q) + off; }
        const int nig = WGM * nN, gid = wgid / nig, fm = gid * WGM, gsz = (nM - fm) < WGM ? (nM - fm) : WGM;
        u.pm = fm + ((wgid % nig) % gsz); u.pn = (wgid % nig) / gsz; return true;
    }
    __device__ __forceinline__ void a_ready(const Unit&) const {}
    __device__ __forceinline__ void done(const Unit&) const {}
};

__device__ __forceinline__ unsigned cvt_pk_bf16(float lo, float hi) { unsigned r; asm volatile("v_cvt_pk_bf16_f32 %0, %1, %2" : "=v"(r) : "v"(lo), "v"(hi)); return r; }
template <class Epi, class Sched, bool ALIGN_EPI = false, bool SP2 = false>
__device__ __forceinline__ void gemm_phase(PG8_LAS unsigned char* lds, const Gemm g, const Sched& S, const Epi& E) {
    const int tid = threadIdx.x, wid = __builtin_amdgcn_readfirstlane(tid >> 6), lane = tid & 63, wr = wid >> 2, wc = wid & 3, fr = lane & 15, fq = lane >> 4;
    const int K = g.K, nt = K / BK;
    unsigned voffA[2], voffB[2];
#pragma unroll
    for (int i = 0; i < 2; ++i) { int R, C; stage_rc(tid * 16 + i * 8192, R, C); const int Rb = Epi::PERM ? ((R & ~31) + perm32(R & 31)) : R;
        voffA[i] = (unsigned)(R * K + C) * 2u; voffB[i] = (unsigned)(Rb * K + C) * 2u; }
    const size_t kstep = (size_t)(BK * 2);
    const size_t hstep = (size_t)HALF * K * 2;
    const size_t tstep = 2 * hstep;
    const unsigned ldsw = (unsigned)wid * 1024u;
    const int aoff = lds_byte(wr * 64 + fr, fq * 8), boff = lds_byte(wc * 32 + fr, fq * 8);
#define PG8_SA(b, h) (((b) * 2 + (h)) * HTB)
#define PG8_SB(b, h) ((4 + (b) * 2 + (h)) * HTB)
#define PG8_STAGE(bufoff, gbase, voff) do { _Pragma("unroll") for (int _i = 0; _i < 2; ++_i) \
        __builtin_amdgcn_global_load_lds((const unsigned*)((const char*)(gbase) + (voff)[_i]), (PG8_LAS unsigned*)(lds + (bufoff) + ldsw + _i * 8192), 16, 0, 0); } while (0)
#define PG8_LDA(dst, b, h) do { _Pragma("unroll") for (int m = 0; m < 4; ++m) _Pragma("unroll") for (int k = 0; k < 2; ++k) dst[m][k] = *(const PG8_LAS bf16x8*)(lds + PG8_SA(b, h) + aoff + m * 2048 + k * 1024); } while (0)
#define PG8_LDB(dst, b, h) do { _Pragma("unroll") for (int n = 0; n < 2; ++n) _Pragma("unroll") for (int k = 0; k < 2; ++k) dst[n][k] = *(const PG8_LAS bf16x8*)(lds + PG8_SB(b, h) + boff + n * 2048 + k * 1024); } while (0)
#define PG8_MMA(ai, bj, At, Bt) do { __builtin_amdgcn_s_setprio(1); _Pragma("unroll") for (int m = 0; m < 4; ++m) _Pragma("unroll") for (int n = 0; n < 2; ++n) _Pragma("unroll") for (int k = 0; k < 2; ++k) \
        acc[ai][bj][m][n] = __builtin_amdgcn_mfma_f32_16x16x32_bf16(Bt[n][k], At[m][k], acc[ai][bj][m][n], 0, 0, 0); __builtin_amdgcn_s_setprio(0); } while (0)
#define PG8_WAIT_V(n) asm volatile("s_waitcnt vmcnt(" #n ")" ::: "memory")
#define PG8_WAIT_L(n) asm volatile("s_waitcnt lgkmcnt(" #n ")" ::: "memory")
#define PG8_BAR __builtin_amdgcn_s_barrier()
#define PG8_SCHED __builtin_amdgcn_sched_barrier(0)
    Unit cur, nxt; int ui = 0;
    if (!S.next(0, cur)) return;
    f32x4 acc[2][2][4][2];
#pragma unroll
    for (int a = 0; a < 2; ++a)
#pragma unroll
        for (int b = 0; b < 2; ++b)
#pragma unroll
            for (int m = 0; m < 4; ++m)
#pragma unroll
                for (int n = 0; n < 2; ++n) acc[a][b][m][n] = (f32x4){0.f, 0.f, 0.f, 0.f};
    bf16x8 At[4][2], B0[2][2], B1[2][2];
    const char* cA = (const char*)g.A + (size_t)cur.pm * tstep; const char* cB = (const char*)g.Bt + (size_t)cur.pn * tstep;
    S.a_ready(cur);
    if constexpr (SP2) {
        PG8_STAGE(PG8_SB(0, 0), cB, voffB); PG8_STAGE(PG8_SB(0, 1), cB + hstep, voffB); PG8_STAGE(PG8_SA(0, 0), cA, voffA); PG8_STAGE(PG8_SA(0, 1), cA + hstep, voffA);
        if (wr == 1) PG8_BAR;
        PG8_WAIT_V(2); PG8_BAR;
        PG8_STAGE(PG8_SB(1, 0), cB + kstep, voffB); PG8_STAGE(PG8_SA(1, 0), cA + kstep, voffA); PG8_STAGE(PG8_SB(1, 1), cB + hstep + kstep, voffB);
        PG8_WAIT_V(6); PG8_BAR;
    } else {
        PG8_STAGE(PG8_SB(0, 0), cB, voffB); PG8_STAGE(PG8_SA(0, 0), cA, voffA); PG8_STAGE(PG8_SB(0, 1), cB + hstep, voffB); PG8_STAGE(PG8_SA(0, 1), cA + hstep, voffA);
        if (wr == 1) PG8_BAR;
        PG8_WAIT_V(4); PG8_BAR;
        PG8_STAGE(PG8_SB(1, 0), cB + kstep, voffB); PG8_STAGE(PG8_SA(1, 0), cA + kstep, voffA); PG8_STAGE(PG8_SB(1, 1), cB + hstep + kstep, voffB);
        PG8_WAIT_V(6); PG8_BAR;
    }
    for (;;) {
        const bool has_next = S.next(ui + 1, nxt);
        const char* nA = has_next ? (const char*)g.A + (size_t)nxt.pm * tstep : cA; const char* nB = has_next ? (const char*)g.Bt + (size_t)nxt.pn * tstep : cB;
        for (int t = 0; t < nt; t += 2) {
            const bool last = (t == nt - 2);
            const char* a1 = cA + (size_t)(t + 1) * kstep;
            const char* a2 = last ? nA : cA + (size_t)(t + 2) * kstep; const char* b2 = last ? nB : cB + (size_t)(t + 2) * kstep;
            const char* a3 = a2 + kstep; const char* b3 = b2 + kstep;
            if (last && has_next) S.a_ready(nxt);
            if constexpr (SP2) {
            PG8_LDB(B0, 0, 0); PG8_LDB(B1, 0, 1); PG8_SCHED; PG8_LDA(At, 0, 0); PG8_STAGE(PG8_SA(1, 1), a1 + hstep, voffA);
            PG8_WAIT_V(8); PG8_WAIT_L(0); PG8_BAR; PG8_MMA(0, 0, At, B0); PG8_MMA(0, 1, At, B1); PG8_BAR; PG8_SCHED;
            PG8_LDA(At, 0, 1); PG8_STAGE(PG8_SB(0, 0), b2, voffB); PG8_STAGE(PG8_SB(0, 1), b2 + hstep, voffB); PG8_STAGE(PG8_SA(0, 0), a2, voffA);
            PG8_WAIT_V(8); PG8_WAIT_L(0); PG8_BAR; PG8_MMA(1, 0, At, B0); PG8_MMA(1, 1, At, B1); PG8_BAR; PG8_SCHED;
            PG8_LDB(B0, 1, 0); PG8_LDB(B1, 1, 1); PG8_SCHED; PG8_LDA(At, 1, 0); PG8_STAGE(PG8_SA(0, 1), a2 + hstep, voffA);
            PG8_WAIT_V(8); PG8_WAIT_L(0); PG8_BAR; PG8_MMA(0, 0, At, B0); PG8_MMA(0, 1, At, B1); PG8_BAR; PG8_SCHED;
            PG8_LDA(At, 1, 1); PG8_STAGE(PG8_SB(1, 0), b3, voffB); PG8_STAGE(PG8_SB(1, 1), b3 + hstep, voffB); PG8_STAGE(PG8_SA(1, 0), a3, voffA);
            PG8_WAIT_V(8); PG8_WAIT_L(0); PG8_BAR; PG8_MMA(1, 0, At, B0); PG8_MMA(1, 1, At, B1); PG8_BAR; PG8_SCHED;
            } else {
            PG8_LDB(B0, 0, 0); PG8_SCHED; PG8_LDA(At, 0, 0); PG8_STAGE(PG8_SA(1, 1), a1 + hstep, voffA);
            PG8_WAIT_L(8); PG8_BAR; PG8_WAIT_L(0); PG8_MMA(0, 0, At, B0); PG8_BAR; PG8_SCHED;
            PG8_LDB(B1, 0, 1); PG8_STAGE(PG8_SB(0, 0), b2, voffB);
            PG8_BAR; PG8_WAIT_L(0); PG8_MMA(0, 1, At, B1); PG8_BAR;
            PG8_LDA(At, 0, 1); PG8_STAGE(PG8_SA(0, 0), a2, voffA);
            PG8_BAR; PG8_WAIT_L(0); PG8_MMA(1, 0, At, B0); PG8_BAR; PG8_SCHED;
            PG8_STAGE(PG8_SB(0, 1), b2 + hstep, voffB);
            PG8_WAIT_V(6); PG8_BAR; PG8_MMA(1, 1, At, B1); PG8_BAR;
            PG8_LDB(B0, 1, 0); PG8_SCHED; PG8_LDA(At, 1, 0); PG8_STAGE(PG8_SA(0, 1), a2 + hstep, voffA);
            PG8_WAIT_L(8); PG8_BAR; PG8_WAIT_L(0); PG8_MMA(0, 0, At, B0); PG8_BAR; PG8_SCHED;
            PG8_LDB(B1, 1, 1); PG8_STAGE(PG8_SB(1, 0), b3, voffB);
            PG8_BAR; PG8_WAIT_L(0); PG8_MMA(0, 1, At, B1); PG8_BAR;
            PG8_LDA(At, 1, 1); PG8_STAGE(PG8_SA(1, 0), a3, voffA);
            PG8_BAR; PG8_WAIT_L(0); PG8_MMA(1, 0, At, B0); PG8_BAR; PG8_SCHED;
            PG8_STAGE(PG8_SB(1, 1), b3 + hstep, voffB);
            PG8_WAIT_V(6); PG8_BAR; PG8_MMA(1, 1, At, B1); PG8_BAR;
            }
        }
        if constexpr (ALIGN_EPI) { if (wr == 0) PG8_BAR; }
        if constexpr (!Epi::AFTER_DRAIN) { E(acc, cur, wr, wc, fr, fq); S.done(cur); }
        if (!has_next) break;
#pragma unroll
        for (int a = 0; a < 2; ++a)
#pragma unroll
            for (int b = 0; b < 2; ++b)
#pragma unroll
                for (int m = 0; m < 4; ++m)
#pragma unroll
                    for (int n = 0; n < 2; ++n) acc[a][b][m][n] = (f32x4){0.f, 0.f, 0.f, 0.f};
        cur = nxt; cA = nA; cB = nB; ++ui;
        if constexpr (ALIGN_EPI) { if (wr == 1) PG8_BAR; }
    }
    PG8_WAIT_V(0);
    if constexpr (!ALIGN_EPI) { if (wr == 0) PG8_BAR; }
    PG8_BAR;
    if constexpr (Epi::AFTER_DRAIN) { E.fused(acc, cur, wr, wc, fr, fq, lds, wid, lane); S.done(cur); }
#undef PG8_SA
#undef PG8_SB
#undef PG8_STAGE
#undef PG8_LDA
#undef PG8_LDB
#undef PG8_MMA
#undef PG8_WAIT_V
#undef PG8_WAIT_L
#undef PG8_BAR
#undef PG8_SCHED
}
}

#define LAS __attribute__((address_space(3)))
#define DI __device__ __forceinline__
typedef unsigned short bf16_t;
typedef short bf16x8 __attribute__((ext_vector_type(8)));
typedef short s16x4 __attribute__((ext_vector_type(4)));
typedef short v4i16_t __attribute__((ext_vector_type(4)));
typedef float f32x4 __attribute__((ext_vector_type(4)));
typedef float f32x2_t __attribute__((ext_vector_type(2)));
typedef __bf16 bf16x2_t __attribute__((ext_vector_type(2)));
typedef unsigned u32x4 __attribute__((ext_vector_type(4)));
typedef unsigned u32x2 __attribute__((ext_vector_type(2)));

constexpr int NTOK = 65536, DM = 1024, SEQ = 8192;
constexpr size_t MiB = 1u << 20;
constexpr size_t WS_MOD = 0;
constexpr size_t WS_INVF = 256 * 1024;
constexpr size_t WS_BAR = 768 * 1024;
constexpr size_t WS_SW1 = 512 * 1024;
constexpr size_t WS_W0IN = 1 * MiB, WS_W0OUT = 13 * MiB, WS_W1IN = 17 * MiB, WS_W1OUT = 33 * MiB;
constexpr size_t WS_SSQ = 37 * MiB;
constexpr size_t WS_H = 48 * MiB;
constexpr size_t WS_ACT = 176 * MiB;
constexpr size_t WS_Q0 = WS_ACT, WS_K0 = WS_ACT + 128 * MiB, WS_V0 = WS_ACT + 256 * MiB;
constexpr size_t WS_Q1 = WS_ACT, WS_K1 = WS_ACT + 256 * MiB, WS_V1 = WS_ACT + 512 * MiB;
constexpr size_t WS_END = WS_ACT + 768 * MiB;
constexpr int LDS_BYTES = 147456;
constexpr float EPSF = 1e-6f;

DI unsigned pkbf(float lo, float hi) { f32x2_t v = {lo, hi}; bf16x2_t b = __builtin_convertvector(v, bf16x2_t); return __builtin_bit_cast(unsigned, b); }
DI float bflo(unsigned u) { return __builtin_bit_cast(float, u << 16); }
DI float bfhi(unsigned u) { return __builtin_bit_cast(float, u & 0xffff0000u); }
DI float ex2(float x) { return __builtin_amdgcn_exp2f(x); }
DI f32x4 mfma16(bf16x8 a, bf16x8 b, f32x4 c) { return __builtin_amdgcn_mfma_f32_16x16x32_bf16(a, b, c, 0, 0, 0); }
DI s16x4 tr_read(const LAS unsigned char* p) { return __builtin_bit_cast(s16x4, __builtin_amdgcn_ds_read_tr16_b64_v4i16((LAS v4i16_t*)p)); }
DI bf16x8 cat4(s16x4 lo, s16x4 hi) { return __builtin_shufflevector(lo, hi, 0, 1, 2, 3, 4, 5, 6, 7); }
DI bf16x8 pack8(f32x4 a, f32x4 b) { u32x4 p; p.x = pkbf(a[0], a[1]); p.y = pkbf(a[2], a[3]); p.z = pkbf(b[0], b[1]); p.w = pkbf(b[2], b[3]); return __builtin_bit_cast(bf16x8, p); }
DI float silu_f(float g) { return g * __builtin_amdgcn_rcpf(1.f + ex2(-1.4426950408889634f * g)); }
#define LDS_BARRIER() do { asm volatile("s_waitcnt lgkmcnt(0)" ::: "memory"); __builtin_amdgcn_s_barrier(); asm volatile("" ::: "memory"); } while (0)
DI float wave_sum(float v) {
#pragma unroll
    for (int o = 1; o < 64; o <<= 1) v += __shfl_xor(v, o);
    return v;
}
DI float dpp_f(float v, const int ctrl_sel) {
    const int x = __builtin_bit_cast(int, v); int r;
    if (ctrl_sel == 0) r = __builtin_amdgcn_update_dpp(x, x, 0xB1, 0xF, 0xF, false);
    else if (ctrl_sel == 1) r = __builtin_amdgcn_update_dpp(x, x, 0x4E, 0xF, 0xF, false);
    else if (ctrl_sel == 2) r = __builtin_amdgcn_update_dpp(x, x, 0x141, 0xF, 0xF, false);
    else r = __builtin_amdgcn_update_dpp(x, x, 0x140, 0xF, 0xF, false);
    return __builtin_bit_cast(float, r); }
DI float row16_sum(float v) { v += dpp_f(v, 0); v += dpp_f(v, 1); v += dpp_f(v, 2); v += dpp_f(v, 3); return v; }
DI float ssq8(u32x4 v) { float s = 0.f;
#pragma unroll
    for (int e = 0; e < 4; ++e) { const float a = bflo(v[e]), b = bfhi(v[e]); s += a * a + b * b; }
    return s; }

typedef const f32x4 (&AccRef)[2][2][4][2];
constexpr float INV2PI_HI = 0.15915493667125702f, INV2PI_LO = 6.4206382432985265e-09f;

struct EpiA0 {
    static constexpr bool PERM = true, AFTER_DRAIN = false;
    bf16_t *Q, *K, *V; const int* pos; const float* invf;
    DI void operator()(AccRef acc, const pg8::Unit& u, int wr, int wc, int fr, int fq) const {
        const int row0 = u.pm * 256 + wr * 64 + fr;
        if (u.pn < 8) {
            bf16_t* base = (u.pn < 4 ? Q : K) + (u.pn & 3) * 256;
            const float sc = u.pn < 4 ? 1.f : 0.0625f;
            const int cl = wc * 32 + 8 * fq;
            const f32x4 f0 = *(const f32x4*)(invf + cl), f1 = *(const f32x4*)(invf + cl + 4);
#pragma unroll
            for (int ai = 0; ai < 2; ++ai)
#pragma unroll
                for (int m = 0; m < 4; ++m) {
                    const int row = row0 + ai * 128 + m * 16;
                    const float p = (float)pos[row];
                    float o1[8], o2[8];
#pragma unroll
                    for (int n = 0; n < 2; ++n)
#pragma unroll
                        for (int i = 0; i < 4; ++i) {
                            const float ang = p * (n == 0 ? f0[i] : f1[i]);
                            const float hi = ang * INV2PI_HI;
                            float lo = __builtin_fmaf(ang, INV2PI_HI, -hi); lo = __builtin_fmaf(ang, INV2PI_LO, lo);
                            const float r = __builtin_amdgcn_fractf(hi) + lo;
                            const float s = __builtin_amdgcn_sinf(r), c = __builtin_amdgcn_cosf(r);
                            const float t1 = acc[ai][0][m][n][i], t2 = acc[ai][1][m][n][i];
                            o1[4 * n + i] = (t1 * c - t2 * s) * sc; o2[4 * n + i] = (t1 * s + t2 * c) * sc;
                        }
                    bf16_t* rp = base + (size_t)row * 1024 + cl;
                    u32x4 w1, w2;
                    w1.x = pkbf(o1[0], o1[1]); w1.y = pkbf(o1[2], o1[3]); w1.z = pkbf(o1[4], o1[5]); w1.w = pkbf(o1[6], o1[7]);
                    w2.x = pkbf(o2[0], o2[1]); w2.y = pkbf(o2[2], o2[3]); w2.z = pkbf(o2[4], o2[5]); w2.w = pkbf(o2[6], o2[7]);
                    *(u32x4*)rp = w1; *(u32x4*)(rp + 128) = w2;
                }
        } else {
            const int col0 = (u.pn - 8) * 256 + wc * 32 + 8 * fq;
#pragma unroll
            for (int ai = 0; ai < 2; ++ai)
#pragma unroll
                for (int m = 0; m < 4; ++m) {
                    bf16_t* rp = V + (size_t)(row0 + ai * 128 + m * 16) * 2048 + col0;
#pragma unroll
                    for (int bj = 0; bj < 2; ++bj) { const f32x4 v0 = acc[ai][bj][m][0], v1 = acc[ai][bj][m][1];
                        u32x4 w; w.x = pkbf(v0[0], v0[1]); w.y = pkbf(v0[2], v0[3]); w.z = pkbf(v1[0], v1[1]); w.w = pkbf(v1[2], v1[3]);
                        *(u32x4*)(rp + bj * 128) = w; }
                }
        }
    }
};

DI float rstd16(const float* ssq1, int row) {
    const f32x4 a = *(const f32x4*)(ssq1 + (size_t)row * 4);
    return __builtin_amdgcn_rsqf(((a[0] + a[1]) + (a[2] + a[3])) * (1.f / 1024.f) + EPSF);
}
struct EpiA1 {
    static constexpr bool PERM = true, AFTER_DRAIN = false;
    bf16_t* Q; const float* ssq1; const float* sw;
    DI void operator()(AccRef acc, const pg8::Unit& u, int wr, int wc, int fr, int fq) const {
        const int row0 = u.pm * 256 + wr * 64 + fr;
        bf16_t* base = Q + (size_t)(u.pn >> 3) * ((size_t)NTOK * 2048);
        const int col0 = (u.pn & 7) * 256 + wc * 32 + 8 * fq;
        const float* swp = sw + (size_t)(u.pm >> 5) * 8192 + u.pn * 256 + wc * 32 + 8 * fq;
        f32x4 sv[2][2];
#pragma unroll
        for (int bj = 0; bj < 2; ++bj) { sv[bj][0] = *(const f32x4*)(swp + bj * 128); sv[bj][1] = *(const f32x4*)(swp + bj * 128 + 4); }
#pragma unroll
        for (int ai = 0; ai < 2; ++ai)
#pragma unroll
            for (int m = 0; m < 4; ++m) {
                const int row = row0 + ai * 128 + m * 16;
                const float rs = rstd16(ssq1, row);
                bf16_t* rp = base + (size_t)row * 2048 + col0;
#pragma unroll
                for (int bj = 0; bj < 2; ++bj) { const f32x4 v0 = acc[ai][bj][m][0] * rs + sv[bj][0], v1 = acc[ai][bj][m][1] * rs + sv[bj][1];
                    u32x4 w; w.x = pkbf(v0[0], v0[1]); w.y = pkbf(v0[2], v0[3]); w.z = pkbf(v1[0], v1[1]); w.w = pkbf(v1[2], v1[3]);
                    *(u32x4*)(rp + bj * 128) = w; }
            }
    }
};

template <int L> struct EpiG {
    static constexpr bool PERM = true, AFTER_DRAIN = false;
    bf16_t* O; const float* ssq; const float* gn; const float* sw;
    DI void operator()(AccRef acc, const pg8::Unit& u, int wr, int wc, int fr, int fq) const {
        const int row0 = u.pm * 256 + wr * 64 + fr;
        const int col0 = u.pn * 256 + wc * 32 + 8 * fq, head = u.pn >> 1;
        float gnv[2][8];
#pragma unroll
        for (int bj = 0; bj < 2; ++bj)
#pragma unroll
            for (int e = 0; e < 8; ++e) gnv[bj][e] = (L == 0) ? gn[col0 + bj * 128 + e] : 1.f;
#pragma unroll
        for (int ai = 0; ai < 2; ++ai)
#pragma unroll
            for (int m = 0; m < 4; ++m) {
                const int row = row0 + ai * 128 + m * 16;
                float rstd = 1.f, rs1 = 1.f;
                if (L == 1) rs1 = rstd16(ssq, row);
                if (L == 0) { const float* sp = ssq + ((size_t)row * 4 + head) * 8; const f32x4 s0 = *(const f32x4*)sp, s1 = *(const f32x4*)(sp + 4);
                    const float tot = ((s0[0] + s0[1]) + (s0[2] + s0[3])) + ((s1[0] + s1[1]) + (s1[2] + s1[3]));
                    rstd = __builtin_amdgcn_rsqf(tot * (1.f / 512.f) + EPSF); }
                bf16_t* rp = O + (size_t)row * 2048 + col0;
#pragma unroll
                for (int bj = 0; bj < 2; ++bj) {
                    const u32x4 ov = *(const u32x4*)(rp + bj * 128);
                    f32x4 g0 = acc[ai][bj][m][0], g1 = acc[ai][bj][m][1];
                    if (L == 1) { const float* swp = sw + (size_t)(u.pm >> 5) * 8192 + 6144 + col0 + bj * 128; g0 = g0 * rs1 + *(const f32x4*)swp; g1 = g1 * rs1 + *(const f32x4*)(swp + 4); }
                    float r[8];
#pragma unroll
                    for (int e = 0; e < 4; ++e) { const float ga = (e < 2 ? g0[2 * e] : g1[2 * e - 4]), gb = (e < 2 ? g0[2 * e + 1] : g1[2 * e - 3]);
                        r[2 * e] = bflo(ov[e]) * silu_f(ga) * (rstd * gnv[bj][2 * e]); r[2 * e + 1] = bfhi(ov[e]) * silu_f(gb) * (rstd * gnv[bj][2 * e + 1]); }
                    u32x4 w; w.x = pkbf(r[0], r[1]); w.y = pkbf(r[2], r[3]); w.z = pkbf(r[4], r[5]); w.w = pkbf(r[6], r[7]);
                    *(u32x4*)(rp + bj * 128) = w;
                }
            }
    }
};

struct EpiOut {
    static constexpr bool PERM = true, AFTER_DRAIN = false;
    const float* xin; float* xout; const float* gate;
    DI void operator()(AccRef acc, const pg8::Unit& u, int wr, int wc, int fr, int fq) const {
        const int row0 = u.pm * 256 + wr * 64 + fr;
        const int col0 = u.pn * 256 + wc * 32 + 8 * fq;
        const float* gp = gate + (size_t)(u.pm >> 5) * 3072 + col0;
        f32x4 gv[2][2];
#pragma unroll
        for (int bj = 0; bj < 2; ++bj) { gv[bj][0] = *(const f32x4*)(gp + bj * 128); gv[bj][1] = *(const f32x4*)(gp + bj * 128 + 4); }
#pragma unroll
        for (int ai = 0; ai < 2; ++ai)
#pragma unroll
            for (int m = 0; m < 4; ++m) {
                const size_t off = (size_t)(row0 + ai * 128 + m * 16) * 1024 + col0;
#pragma unroll
                for (int bj = 0; bj < 2; ++bj) {
                    const f32x4 x0 = *(const f32x4*)(xin + off + bj * 128), x1 = *(const f32x4*)(xin + off + bj * 128 + 4);
                    *(f32x4*)(xout + off + bj * 128) = x0 + gv[bj][0] * acc[ai][bj][m][0];
                    *(f32x4*)(xout + off + bj * 128 + 4) = x1 + gv[bj][1] * acc[ai][bj][m][1];
                }
            }
    }
};

struct EpiOutLN {
    static constexpr bool PERM = true, AFTER_DRAIN = false;
    const float* xin; float* xout; const float* gate; bf16_t* H; const float* g1; const float* scale1; float* ssq1; LAS float* red;
    DI void operator()(AccRef acc, const pg8::Unit& u, int wr, int wc, int fr, int fq) const {
        const int row0 = u.pm * 256 + wr * 64 + fr;
        const int col0 = u.pn * 256 + wc * 32 + 8 * fq;
        const float* gp = gate + (size_t)(u.pm >> 5) * 3072 + col0;
        const float* sp = scale1 + (size_t)(u.pm >> 5) * 3072 + col0;
        float sq[8];
#pragma unroll
        for (int i = 0; i < 8; ++i) sq[i] = 0.f;
#pragma unroll
        for (int bj = 0; bj < 2; ++bj) {
            const f32x4 gv0 = *(const f32x4*)(gp + bj * 128), gv1 = *(const f32x4*)(gp + bj * 128 + 4);
            const f32x4 av0 = *(const f32x4*)(g1 + col0 + bj * 128) * (*(const f32x4*)(sp + bj * 128) + 1.f), av1 = *(const f32x4*)(g1 + col0 + bj * 128 + 4) * (*(const f32x4*)(sp + bj * 128 + 4) + 1.f);
#pragma unroll
            for (int ai = 0; ai < 2; ++ai)
#pragma unroll
                for (int m = 0; m < 4; ++m) {
                    const size_t off = (size_t)(row0 + ai * 128 + m * 16) * 1024 + col0 + bj * 128;
                    const f32x4 x0 = *(const f32x4*)(xin + off) + gv0 * acc[ai][bj][m][0], x1 = *(const f32x4*)(xin + off + 4) + gv1 * acc[ai][bj][m][1];
                    *(f32x4*)(xout + off) = x0; *(f32x4*)(xout + off + 4) = x1;
                    sq[ai * 4 + m] += ((x0[0] * x0[0] + x0[1] * x0[1]) + (x0[2] * x0[2] + x0[3] * x0[3])) + ((x1[0] * x1[0] + x1[1] * x1[1]) + (x1[2] * x1[2] + x1[3] * x1[3]));
                    const f32x4 h0 = x0 * av0, h1 = x1 * av1;
                    u32x4 w; w.x = pkbf(h0[0], h0[1]); w.y = pkbf(h0[2], h0[3]); w.z = pkbf(h1[0], h1[1]); w.w = pkbf(h1[2], h1[3]);
                    *(u32x4*)(H + off) = w;
                }
        }
#pragma unroll
        for (int i = 0; i < 8; ++i) {
            float t = sq[i]; t += __shfl_xor(t, 16); t += __shfl_xor(t, 32);
            if (fq == 0) red[wc * 256 + (i >> 2) * 128 + wr * 64 + (i & 3) * 16 + fr] = t;
        }
        asm volatile("s_waitcnt lgkmcnt(0)" ::: "memory"); __builtin_amdgcn_s_barrier(); asm volatile("" ::: "memory");
        { const int tl = threadIdx.x; if (tl < 256) ssq1[(size_t)(u.pm * 256 + tl) * 4 + u.pn] = (red[tl] + red[256 + tl]) + (red[512 + tl] + red[768 + tl]); }
        asm volatile("s_waitcnt lgkmcnt(0)" ::: "memory");
    }
};

DI unsigned f2bf(float f) { unsigned u = __builtin_bit_cast(unsigned, f); return (u + 0x7fffu + ((u >> 16) & 1u)) >> 16; }
DI unsigned pk2(float lo, float hi) { return f2bf(lo) | (f2bf(hi) << 16); }
DI void p0_transpose_item(const float* W, int K, int N, bf16_t* WT, LAS float* scr, int item, int lane) {
    const int nblk = N / 32, kb = item / nblk, nb = item % nblk, k0 = 64 * kb, n0 = 32 * nb;
#pragma unroll 8
    for (int i = 0; i < 32; ++i) { const int kk = 2 * i + (lane >> 5); scr[kk * 33 + (lane & 31)] = W[(size_t)(k0 + kk) * N + n0 + (lane & 31)]; }
    asm volatile("s_waitcnt lgkmcnt(0)" ::: "memory");
    const int c = lane & 7;
#pragma unroll
    for (int j = 0; j < 4; ++j) { const int n = (lane >> 3) + 8 * j; const LAS float* s = scr + (8 * c) * 33 + n;
        u32x4 o; o.x = pk2(s[0 * 33], s[1 * 33]); o.y = pk2(s[2 * 33], s[3 * 33]); o.z = pk2(s[4 * 33], s[5 * 33]); o.w = pk2(s[6 * 33], s[7 * 33]);
        *(u32x4*)(WT + (size_t)(n0 + n) * K + k0 + 8 * c) = o; }
    asm volatile("s_waitcnt lgkmcnt(0)" ::: "memory");
}

DI void p0_phase(LAS unsigned char* lds, const float* cvec, const float* ada_w, const float* ada_b, const float* w0in, const float* w0out, const float* w1in, const float* w1out,
                 unsigned char* ws, int bid, int G) {
    const int tid = threadIdx.x, lane = tid & 63, w = __builtin_amdgcn_readfirstlane(tid >> 6);
    float* mod = (float*)(ws + WS_MOD);
    if (bid == G - 1 && tid < 128) { float* invf = (float*)(ws + WS_INVF); invf[tid] = 1.0f / powf(10000.0f, (float)(2 * tid) / 256.0f); }
    LAS float* cond = (LAS float*)lds;
    LAS float* red = (LAS float*)(lds + 32768);
    if (bid < 96) {
        for (int i = tid; i < 8192; i += 512) { const float v = cvec[i]; cond[i] = v / (1.f + expf(-v)); }
        __syncthreads();
    }
    for (int mi = bid; mi < 96; mi += G) {
        const int n0 = mi * 64, layer = n0 / 3072, nn = n0 % 3072 + lane;
        const float* wp = ada_w + (size_t)layer * 1024 * 3072 + nn;
        float acc[8];
#pragma unroll
        for (int b = 0; b < 8; ++b) acc[b] = 0.f;
#pragma unroll 8
        for (int kk = 0; kk < 128; ++kk) { const int k = w * 128 + kk; const float wv = wp[(size_t)k * 3072];
#pragma unroll
            for (int b = 0; b < 8; ++b) acc[b] += cond[b * 1024 + k] * wv; }
#pragma unroll
        for (int b = 0; b < 8; ++b) red[(w * 8 + b) * 64 + lane] = acc[b];
        __syncthreads();
        { const int b = tid >> 6; float s = 0.f;
#pragma unroll
          for (int ww = 0; ww < 8; ++ww) s += red[(ww * 8 + b) * 64 + lane];
          mod[((size_t)layer * 8 + b) * 3072 + nn] = s + ada_b[layer * 3072 + nn]; }
        __syncthreads();
    }
    __syncthreads();
    LAS float* scr = (LAS float*)(lds + 65536 + w * 8704);
    const int gw = bid * 8 + w, NGW = G * 8;
    constexpr int I0 = (1024 / 64) * (6144 / 32), I1 = (2048 / 64) * (1024 / 32), I2 = (1024 / 64) * (8192 / 32), I3 = I1;
    for (int it = gw; it < I0 + I1 + I2 + I3; it += NGW) {
        int r = it;
        if (r < I0) { p0_transpose_item(w0in, 1024, 6144, (bf16_t*)(ws + WS_W0IN), scr, r, lane); continue; } r -= I0;
        if (r < I1) { p0_transpose_item(w0out, 2048, 1024, (bf16_t*)(ws + WS_W0OUT), scr, r, lane); continue; } r -= I1;
        if (r < I2) { p0_transpose_item(w1in, 1024, 8192, (bf16_t*)(ws + WS_W1IN), scr, r, lane); continue; } r -= I2;
        p0_transpose_item(w1out, 2048, 1024, (bf16_t*)(ws + WS_W1OUT), scr, r, lane);
    }
}

DI void sw_items(LAS unsigned char* lds, const float* modl, const float* W, int N, float* sw, int bid, int G) {
    const int tid = threadIdx.x, lane = tid & 63, w = __builtin_amdgcn_readfirstlane(tid >> 6);
    LAS float* vec = (LAS float*)lds;
    LAS float* red = (LAS float*)(lds + 32768);
    const int nitems = N / 64;
    if (bid < nitems) {
        for (int i = tid; i < 8192; i += 512) vec[i] = modl[(size_t)(i >> 10) * 3072 + (i & 1023)];
        __syncthreads();
    }
    for (int mi = bid; mi < nitems; mi += G) {
        const int n = mi * 64 + lane;
        const float* wp = W + n;
        float acc[8];
#pragma unroll
        for (int b = 0; b < 8; ++b) acc[b] = 0.f;
#pragma unroll 8
        for (int kk = 0; kk < 128; ++kk) { const int k = w * 128 + kk; const float wv = wp[(size_t)k * N];
#pragma unroll
            for (int b = 0; b < 8; ++b) acc[b] += vec[b * 1024 + k] * wv; }
#pragma unroll
        for (int b = 0; b < 8; ++b) red[(w * 8 + b) * 64 + lane] = acc[b];
        __syncthreads();
        { const int b = tid >> 6; float sm = 0.f;
#pragma unroll
          for (int ww = 0; ww < 8; ++ww) sm += red[(ww * 8 + b) * 64 + lane];
          sw[(size_t)b * N + n] = sm; }
        __syncthreads();
    }
    __syncthreads();
}

DI void ln_phase(const float* xin, bf16_t* h, const float* ng, const float* modl, int gw, int NGW, int lane) {
    for (int m = gw; m < NTOK; m += NGW) {
        const int b = m >> 13;
        const float* xr = xin + (size_t)m * 1024;
        const float* sh = modl + (size_t)b * 3072; const float* scl = sh + 1024;
        f32x4 v[4];
        v[0] = *(const f32x4*)(xr + 8 * lane); v[1] = *(const f32x4*)(xr + 8 * lane + 4); v[2] = *(const f32x4*)(xr + 512 + 8 * lane); v[3] = *(const f32x4*)(xr + 512 + 8 * lane + 4);
        float ss = 0.f;
#pragma unroll
        for (int i = 0; i < 4; ++i) ss += (v[i][0] * v[i][0] + v[i][1] * v[i][1]) + (v[i][2] * v[i][2] + v[i][3] * v[i][3]);
        ss = wave_sum(ss);
        const float rstd = 1.0f / sqrtf(ss * (1.f / 1024.f) + EPSF);
        float o[16];
#pragma unroll
        for (int i = 0; i < 4; ++i) { const int c = (i >> 1) * 512 + 8 * lane + (i & 1) * 4;
            const f32x4 g = *(const f32x4*)(ng + c), s1 = *(const f32x4*)(scl + c), s0 = *(const f32x4*)(sh + c);
#pragma unroll
            for (int e = 0; e < 4; ++e) o[4 * i + e] = v[i][e] * rstd * g[e] * (1.f + s1[e]) + s0[e]; }
        u32x4 w0, w1;
        w0.x = pkbf(o[0], o[1]); w0.y = pkbf(o[2], o[3]); w0.z = pkbf(o[4], o[5]); w0.w = pkbf(o[6], o[7]);
        w1.x = pkbf(o[8], o[9]); w1.y = pkbf(o[10], o[11]); w1.z = pkbf(o[12], o[13]); w1.w = pkbf(o[14], o[15]);
        *(u32x4*)(h + (size_t)m * 1024 + 8 * lane) = w0; *(u32x4*)(h + (size_t)m * 1024 + 512 + 8 * lane) = w1;
    }
}

constexpr int R_QSTR = 528, R_KSTR = 544, R_VSTR = 160, R_PSTR = 144;
constexpr int R_QL = 0, R_KL = R_QL + 64 * R_QSTR, R_VL = R_KL + 64 * R_KSTR, R_PL = R_VL + 64 * R_VSTR, R_XL = R_PL + 64 * R_PSTR, R_SL = R_XL + 16384, R_END = R_SL + 4096;
static_assert(R_END <= LDS_BYTES, "retention LDS");

template <int KH> DI void ret_rd16(s16x4 (&qb)[16], unsigned own_addr, unsigned oth_addr) {
    asm volatile("ds_read_b64 %0, %16 offset:%18\n\t"
                        "ds_read_b64 %1, %16 offset:%19\n\t"
                        "ds_read_b64 %2, %17 offset:%18\n\t"
                        "ds_read_b64 %3, %17 offset:%19\n\t"
                        "ds_read_b64 %4, %16 offset:%20\n\t"
                        "ds_read_b64 %5, %16 offset:%21\n\t"
                        "ds_read_b64 %6, %17 offset:%20\n\t"
                        "ds_read_b64 %7, %17 offset:%21\n\t"
                        "ds_read_b64 %8, %16 offset:%22\n\t"
                        "ds_read_b64 %9, %16 offset:%23\n\t"
                        "ds_read_b64 %10, %17 offset:%22\n\t"
                        "ds_read_b64 %11, %17 offset:%23\n\t"
                        "ds_read_b64 %12, %16 offset:%24\n\t"
                        "ds_read_b64 %13, %16 offset:%25\n\t"
                        "ds_read_b64 %14, %17 offset:%24\n\t"
                        "ds_read_b64 %15, %17 offset:%25"
                 : "=&v"(qb[0]), "=&v"(qb[1]), "=&v"(qb[2]), "=&v"(qb[3]), "=&v"(qb[4]), "=&v"(qb[5]), "=&v"(qb[6]), "=&v"(qb[7]), "=&v"(qb[8]), "=&v"(qb[9]), "=&v"(qb[10]), "=&v"(qb[11]), "=&v"(qb[12]), "=&v"(qb[13]), "=&v"(qb[14]), "=&v"(qb[15])
                 : "v"(own_addr), "v"(oth_addr), "n"(0 * 16 * R_QSTR + (2 * KH + 0) * 64 + 0 * 32), "n"(0 * 16 * R_QSTR + (2 * KH + 0) * 64 + 1 * 32), "n"(1 * 16 * R_QSTR + (2 * KH + 0) * 64 + 0 * 32), "n"(1 * 16 * R_QSTR + (2 * KH + 0) * 64 + 1 * 32), "n"(0 * 16 * R_QSTR + (2 * KH + 1) * 64 + 0 * 32), "n"(0 * 16 * R_QSTR + (2 * KH + 1) * 64 + 1 * 32), "n"(1 * 16 * R_QSTR + (2 * KH + 1) * 64 + 0 * 32), "n"(1 * 16 * R_QSTR + (2 * KH + 1) * 64 + 1 * 32)
                 : "memory");
}

DI void ret_wait16(s16x4 (&qb)[16]) {
    asm volatile("s_waitcnt lgkmcnt(0)" : "+v"(qb[0]), "+v"(qb[1]), "+v"(qb[2]), "+v"(qb[3]), "+v"(qb[4]), "+v"(qb[5]), "+v"(qb[6]), "+v"(qb[7]) :: "memory");
    asm volatile("" : "+v"(qb[8]), "+v"(qb[9]), "+v"(qb[10]), "+v"(qb[11]), "+v"(qb[12]), "+v"(qb[13]), "+v"(qb[14]), "+v"(qb[15]) :: "memory");
}

template <int SH> DI void ret_phase(LAS unsigned char* lds, const bf16_t* Q0, const bf16_t* K0, bf16_t* V0, float* ssq, int vcu, int G, int magic) {
    const int tid = threadIdx.x, lane = tid & 63, w = __builtin_amdgcn_readfirstlane(tid >> 6), fr = lane & 15, fq = lane >> 4;
    const int et = w & 3, dh = w >> 2;
    for (int it = vcu; it < 256; it += G) {
        const int bh = it >> 3, dvt = it & 7, b = bh >> 2, h = bh & 3;
        const float lg2 = log2f(1.0f - exp2f(-5.0f - (float)h));
        const float cd = exp2f(lg2 * 64.f);
        float kd[2][8];
#pragma unroll
        for (int s = 0; s < 2; ++s)
#pragma unroll
            for (int jj = 0; jj < 8; ++jj) kd[s][jj] = exp2f(lg2 * (float)(63 - (32 * s + 16 * (jj >> 2) + 4 * fq + (jj & 3))));
        const int ct_own = 2 * dh, ct_oth = 2 * (1 - dh);
        float qd[2];
#pragma unroll
        for (int i = 0; i < 2; ++i) qd[i] = exp2f(lg2 * (float)(16 * (ct_own + i) + fr + 1));
        f32x4 st[8];
#pragma unroll
        for (int t = 0; t < 8; ++t) st[t] = (f32x4){0.f, 0.f, 0.f, 0.f};
        const size_t tok0 = (size_t)b * SEQ;
        u32x4 qr[4], kr[4], vr;
#define R_ISSUE(j) do { _Pragma("unroll") for (int i_ = 0; i_ < 4; ++i_) { const int ch_ = tid + 512 * i_; const size_t g_ = (tok0 + (size_t)(j) * 64 + (ch_ >> 5)) * 1024 + h * 256 + (ch_ & 31) * 8; \
            qr[i_] = *(const u32x4*)(Q0 + g_); kr[i_] = *(const u32x4*)(K0 + g_); } \
            vr = *(const u32x4*)(V0 + (tok0 + (size_t)(j) * 64 + (tid >> 3)) * 2048 + h * 512 + dvt * 64 + (tid & 7) * 8); } while (0)
#define R_WRITE() do { _Pragma("unroll") for (int i_ = 0; i_ < 4; ++i_) { const int ch_ = tid + 512 * i_; \
            *(LAS u32x4*)(lds + R_QL + (ch_ >> 5) * R_QSTR + (ch_ & 31) * 16) = qr[i_]; *(LAS u32x4*)(lds + R_KL + (ch_ >> 5) * R_KSTR + (ch_ & 31) * 16) = kr[i_]; } \
            *(LAS u32x4*)(lds + R_VL + (tid >> 3) * R_VSTR + (tid & 7) * 16) = vr; } while (0)
        R_ISSUE(0); R_WRITE(); LDS_BARRIER();
        for (int j = 0; j < 128; ++j) {
            if (SH != 1 && j + 1 < 128) R_ISSUE(j + 1);
            if (SH == 0 && j > 0 && tid < 64) { const LAS float* sl = (const LAS float*)(lds + R_SL) + tid; float sa = 0.f;
#pragma unroll
                for (int u = 0; u < 16; ++u) sa += sl[u * 64];
                ssq[((tok0 + (size_t)(j - 1) * 64 + tid) * 4 + h) * 8 + dvt] = sa; }
            const unsigned qo_a = (unsigned)(size_t)(lds + R_QL + (16 * ct_own + fr) * R_QSTR + (128 * dh + 4 * fq) * 2);
            const unsigned qt_a = (unsigned)(size_t)(lds + R_QL + (16 * ct_oth + fr) * R_QSTR + (128 * dh + 4 * fq) * 2);
            s16x4 qb[16];
            ret_rd16<0>(qb, qo_a, qt_a);
            {
                const int kt = w & 3, ctp = w >> 2;
                f32x4 sc0 = (f32x4){0.f, 0.f, 0.f, 0.f}, sc1 = sc0;
                const LAS unsigned char* kp = lds + R_KL + (16 * kt + fr) * R_KSTR + fq * 16;
                const LAS unsigned char* qp = lds + R_QL + (32 * ctp + fr) * R_QSTR + fq * 16;
#pragma unroll
                for (int ks = 0; ks < 8; ++ks) {
                    const bf16x8 kf = *(const LAS bf16x8*)(kp + ks * 64), q0 = *(const LAS bf16x8*)(qp + ks * 64), q1 = *(const LAS bf16x8*)(qp + 16 * R_QSTR + ks * 64);
                    sc0 = mfma16(kf, q0, sc0); sc1 = mfma16(kf, q1, sc1);
                }
                const int c0 = 32 * ctp + fr, kbase = 16 * kt + 4 * fq;
                float p0[4], p1[4];
#pragma unroll
                for (int r = 0; r < 4; ++r) { const int d0 = c0 - (kbase + r), d1 = d0 + 16;
                    p0[r] = sc0[r] * ex2(lg2 * (float)(d0 < 0 ? -d0 : d0)); p1[r] = sc1[r] * ex2(lg2 * (float)(d1 < 0 ? -d1 : d1)); }
                u32x2 w0, w1; w0.x = pkbf(p0[0], p0[1]); w0.y = pkbf(p0[2], p0[3]); w1.x = pkbf(p1[0], p1[1]); w1.y = pkbf(p1[2], p1[3]);
                *(LAS u32x2*)(lds + R_PL + c0 * R_PSTR + kbase * 2) = w0; *(LAS u32x2*)(lds + R_PL + (c0 + 16) * R_PSTR + kbase * 2) = w1;
            }
            f32x4 own[2], oth[2];
#pragma unroll
            for (int i = 0; i < 2; ++i) { own[i] = (f32x4){0.f, 0.f, 0.f, 0.f}; oth[i] = own[i]; }
            {
                ret_wait16(qb);
#pragma unroll
                for (int kk = 0; kk < 2; ++kk) {
                    const bf16x8 a = pack8(st[2 * kk], st[2 * kk + 1]);
#pragma unroll
                    for (int i = 0; i < 2; ++i) { own[i] = mfma16(a, cat4(qb[kk * 8 + i * 4], qb[kk * 8 + i * 4 + 1]), own[i]); oth[i] = mfma16(a, cat4(qb[kk * 8 + i * 4 + 2], qb[kk * 8 + i * 4 + 3]), oth[i]); }
                }
                ret_rd16<1>(qb, qo_a, qt_a);
                ret_wait16(qb);
#pragma unroll
                for (int kk = 0; kk < 2; ++kk) {
                    const bf16x8 a = pack8(st[4 + 2 * kk], st[4 + 2 * kk + 1]);
#pragma unroll
                    for (int i = 0; i < 2; ++i) { own[i] = mfma16(a, cat4(qb[kk * 8 + i * 4], qb[kk * 8 + i * 4 + 1]), own[i]); oth[i] = mfma16(a, cat4(qb[kk * 8 + i * 4 + 2], qb[kk * 8 + i * 4 + 3]), oth[i]); }
                }
#pragma unroll
                for (int i = 0; i < 2; ++i) *(LAS f32x4*)(lds + R_XL + ((w * 2 + i) * 64 + lane) * 16) = oth[i];
            }
            bf16x8 vf[2];
#pragma unroll
            for (int s = 0; s < 2; ++s) {
                const LAS unsigned char* va = lds + R_VL + (32 * s + 4 * fq + (fr >> 2)) * R_VSTR + (16 * et + 4 * (fr & 3)) * 2;
                vf[s] = cat4(tr_read(va), tr_read(va + 16 * R_VSTR));
            }
#pragma unroll
            for (int t = 0; t < 8; ++t) st[t] = st[t] * cd;
#pragma unroll
            for (int s = 0; s < 2; ++s) {
                const u32x4 vu = __builtin_bit_cast(u32x4, vf[s]); u32x4 vsu;
#pragma unroll
                for (int e = 0; e < 4; ++e) vsu[e] = pkbf(bflo(vu[e]) * kd[s][2 * e], bfhi(vu[e]) * kd[s][2 * e + 1]);
                const bf16x8 vs = __builtin_bit_cast(bf16x8, vsu);
                const LAS unsigned char* ka = lds + R_KL + (32 * s + 4 * fq + (fr >> 2)) * R_KSTR + (128 * dh + 4 * (fr & 3)) * 2;
#pragma unroll
                for (int t = 0; t < 8; ++t) st[t] = mfma16(cat4(tr_read(ka + t * 32), tr_read(ka + t * 32 + 16 * R_KSTR)), vs, st[t]);
            }
            LDS_BARRIER();
            {
                const int pw = et + 4 * (1 - dh);
#pragma unroll
                for (int i = 0; i < 2; ++i) { const f32x4 o2 = *(const LAS f32x4*)(lds + R_XL + ((pw * 2 + i) * 64 + lane) * 16); own[i] = (own[i] + o2) * qd[i]; }
            }
#pragma unroll
            for (int s = 0; s < 2; ++s)
#pragma unroll
                for (int i = 0; i < 2; ++i) { const LAS unsigned char* pa = lds + R_PL + (16 * (ct_own + i) + fr) * R_PSTR + (32 * s + 4 * fq) * 2;
                    own[i] = mfma16(vf[s], cat4(*(const LAS s16x4*)pa, *(const LAS s16x4*)(pa + 32)), own[i]); }
            if (j + 1 < 128) R_WRITE();
#pragma unroll
            for (int i = 0; i < 2; ++i) {
                const int c = 16 * (ct_own + i) + fr;
                u32x2 ow; ow.x = pkbf(own[i][0], own[i][1]); ow.y = pkbf(own[i][2], own[i][3]);
                const float sq = (own[i][0] * own[i][0] + own[i][1] * own[i][1]) + (own[i][2] * own[i][2] + own[i][3] * own[i][3]);
                if (SH == 0 || sq == (float)magic) *(u32x2*)(V0 + (tok0 + (size_t)j * 64 + c) * 2048 + h * 512 + dvt * 64 + 16 * et + 4 * fq) = ow;
                *(LAS float*)(lds + R_SL + ((et * 4 + fq) * 64 + c) * 4) = sq;
            }
            LDS_BARRIER();
        }
        if (SH == 0 && tid < 64) { const LAS float* sl = (const LAS float*)(lds + R_SL) + tid; float sa = 0.f;
#pragma unroll
            for (int u = 0; u < 16; ++u) sa += sl[u * 64];
            ssq[((tok0 + (size_t)127 * 64 + tid) * 4 + h) * 8 + dvt] = sa; }
        LDS_BARRIER();
#undef R_ISSUE
#undef R_WRITE
    }
}

constexpr int A_KSTR = 288, A_VSTR = 288, A_KT = 64 * A_KSTR, A_VT = 64 * A_VSTR, A_BUF = A_KT + A_VT, A_TAB = 2 * A_BUF, A_END = A_TAB + 1280;
static_assert(A_END <= LDS_BYTES, "attention LDS");
constexpr float LOG2E = 1.4426950408889634f;

template <int SH> DI void att_phase(LAS unsigned char* lds, bf16_t* Q1, const bf16_t* K1, const bf16_t* V1, const float* qg, const float* kg, const float* rel, int vcu, int G, int magic) {
    const int tid = threadIdx.x, lane = tid & 63, w = __builtin_amdgcn_readfirstlane(tid >> 6), fr = lane & 15, fq = lane >> 4;
    const int lrow = tid >> 4, lcc = tid & 15;
    float kgv[8];
#pragma unroll
    for (int e = 0; e < 8; ++e) kgv[e] = kg[lcc * 8 + e];
    LAS float* tab = (LAS float*)(lds + A_TAB);
    float gmx;
    { float a = fmaxf(fabsf(qg[lane]), fabsf(qg[lane + 64])), c = fmaxf(fabsf(kg[lane]), fabsf(kg[lane + 64]));
#pragma unroll
      for (int o = 1; o < 64; o <<= 1) { a = fmaxf(a, __shfl_xor(a, o)); c = fmaxf(c, __shfl_xor(c, o)); }
      gmx = 11.313708498984761f * a * c * LOG2E; }
    for (int it = vcu; it < 4096; it += G) {
        const int b = it >> 9, h = (it >> 5) & 15, jg = it & 31;
        const int jw = 4 * jg + (w >> 1), qoff = (w & 1) * 32;
        const size_t qrow0 = (size_t)b * SEQ + (size_t)jw * 64 + qoff;
        const int rot = (8 * jg) % 12, nst = 12;
#define A_KC(t) (4 * jg - 8 + (((t) + rot) % 12))
        u32x4 kr0, kr1, vr0, vr1;
#define A_ISSUE(kc) do { const int kc_ = (kc) < 0 ? 0 : (kc); const size_t g_ = ((size_t)b * SEQ + (size_t)kc_ * 64 + lrow) * 2048 + h * 128 + lcc * 8; \
            kr0 = *(const u32x4*)(K1 + g_); kr1 = *(const u32x4*)(K1 + g_ + 32 * 2048); vr0 = *(const u32x4*)(V1 + g_); vr1 = *(const u32x4*)(V1 + g_ + 32 * 2048); } while (0)
#define A_WRITE(buf) do { float s0_ = ssq8(kr0), s1_ = ssq8(kr1); \
            s0_ = row16_sum(s0_); s1_ = row16_sum(s1_); \
            const float r0_ = __builtin_amdgcn_rsqf(s0_ * (1.f / 128.f) + EPSF), r1_ = __builtin_amdgcn_rsqf(s1_ * (1.f / 128.f) + EPSF); \
            u32x4 k0_, k1_; \
            _Pragma("unroll") for (int e_ = 0; e_ < 4; ++e_) { k0_[e_] = pkbf(bflo(kr0[e_]) * r0_ * kgv[2 * e_], bfhi(kr0[e_]) * r0_ * kgv[2 * e_ + 1]); \
                k1_[e_] = pkbf(bflo(kr1[e_]) * r1_ * kgv[2 * e_], bfhi(kr1[e_]) * r1_ * kgv[2 * e_ + 1]); } \
            LAS unsigned char* bb_ = lds + (buf) * A_BUF; \
            *(LAS u32x4*)(bb_ + lrow * A_KSTR + lcc * 16) = k0_; *(LAS u32x4*)(bb_ + (lrow + 32) * A_KSTR + lcc * 16) = k1_; \
            *(LAS u32x4*)(bb_ + A_KT + lrow * A_VSTR + lcc * 16) = vr0; *(LAS u32x4*)(bb_ + A_KT + (lrow + 32) * A_VSTR + lcc * 16) = vr1; } while (0)
        A_ISSUE(A_KC(0));
        float bmx, bmn;
        { float v0 = rel[h * 257 + lane], v1 = rel[h * 257 + 64 + lane], v2 = rel[h * 257 + 128 + lane], v3 = rel[h * 257 + 192 + lane], v4 = rel[h * 257 + 256];
          bmx = fmaxf(fmaxf(fmaxf(v0, v1), fmaxf(v2, v3)), v4); bmn = fminf(fminf(fminf(v0, v1), fminf(v2, v3)), v4);
#pragma unroll
          for (int o = 1; o < 64; o <<= 1) { bmx = fmaxf(bmx, __shfl_xor(bmx, o)); bmn = fminf(bmn, __shfl_xor(bmn, o)); } }
        const float mfix = gmx + bmx * LOG2E;
        const bool fast = (2.f * gmx + (bmx - bmn) * LOG2E) <= 120.f;
        if (tid < 320) tab[tid] = rel[h * 257 + (tid < 256 ? tid : 256)] * LOG2E - mfix;
        bf16x8 Qf[2][4];
        {
            const float qsc = 0.08838834764831845f * LOG2E;
#pragma unroll
            for (int qt = 0; qt < 2; ++qt) {
                u32x4 raw[4]; float ss = 0.f;
                const bf16_t* qp = Q1 + (qrow0 + 16 * qt + fr) * 2048 + h * 128 + 8 * fq;
#pragma unroll
                for (int ks = 0; ks < 4; ++ks) { raw[ks] = *(const u32x4*)(qp + 32 * ks); ss += ssq8(raw[ks]); }
                ss += __shfl_xor(ss, 16); ss += __shfl_xor(ss, 32);
                const float rs = __builtin_amdgcn_rsqf(ss * (1.f / 128.f) + EPSF) * qsc;
#pragma unroll
                for (int ks = 0; ks < 4; ++ks) {
                    const f32x4 g0 = *(const f32x4*)(qg + 32 * ks + 8 * fq), g1 = *(const f32x4*)(qg + 32 * ks + 8 * fq + 4);
                    u32x4 pq;
                    pq.x = pkbf(bflo(raw[ks].x) * rs * g0[0], bfhi(raw[ks].x) * rs * g0[1]); pq.y = pkbf(bflo(raw[ks].y) * rs * g0[2], bfhi(raw[ks].y) * rs * g0[3]);
                    pq.z = pkbf(bflo(raw[ks].z) * rs * g1[0], bfhi(raw[ks].z) * rs * g1[1]); pq.w = pkbf(bflo(raw[ks].w) * rs * g1[2], bfhi(raw[ks].w) * rs * g1[3]);
                    Qf[qt][ks] = __builtin_bit_cast(bf16x8, pq);
                }
            }
        }
        f32x4 O[8][2];
#pragma unroll
        for (int nt = 0; nt < 8; ++nt) { O[nt][0] = (f32x4){0.f, 0.f, 0.f, 0.f}; O[nt][1] = O[nt][0]; }
        float mrun[2] = {-1e30f, -1e30f}, lsum[2] = {0.f, 0.f};
        A_WRITE(0);
        LDS_BARRIER();
        for (int t = 0; t < nst; ++t) {
            const int kc = A_KC(t);
            if (SH == 0 && t + 1 < nst) A_ISSUE(A_KC(t + 1));
            const int delta = jw - kc;
            if (kc >= 0 && delta >= 0 && delta <= 8) {
                const LAS unsigned char* kb = lds + (t & 1) * A_BUF;
                const LAS unsigned char* vb = kb + A_KT;
                f32x4 s[4][2];
                if (delta >= 3) { const float bc = tab[256];
#pragma unroll
                    for (int kt = 0; kt < 4; ++kt)
#pragma unroll
                        for (int qt = 0; qt < 2; ++qt) s[kt][qt] = (f32x4){bc, bc, bc, bc};
                } else {
                    const LAS float* tp = tab + (qoff + fr - 4 * fq + 128 - 51 + 64 * delta);
#pragma unroll
                    for (int kt = 0; kt < 4; ++kt)
#pragma unroll
                        for (int qt = 0; qt < 2; ++qt)
#pragma unroll
                            for (int r = 0; r < 4; ++r) s[kt][qt][r] = tp[16 * qt - 16 * kt - r + 51];
                }
#pragma unroll
                for (int kh = 0; kh < 2; ++kh) {
                    bf16x8 kf[2][4];
#pragma unroll
                    for (int kt = 0; kt < 2; ++kt)
#pragma unroll
                        for (int ks = 0; ks < 4; ++ks) kf[kt][ks] = *(const LAS bf16x8*)(kb + (16 * (2 * kh + kt) + fr) * A_KSTR + (32 * ks + 8 * fq) * 2);
#pragma unroll
                    for (int kt = 0; kt < 2; ++kt)
#pragma unroll
                        for (int qt = 0; qt < 2; ++qt) { f32x4 c = s[2 * kh + kt][qt];
#pragma unroll
                            for (int ks = 0; ks < 4; ++ks) c = mfma16(kf[kt][ks], Qf[qt][ks], c);
                            s[2 * kh + kt][qt] = c; }
                }
                if (SH == 3) { lsum[0] += s[0][0][0]; lsum[1] += s[0][1][0]; } else
                if (fast) {
#pragma unroll
                    for (int qt = 0; qt < 2; ++qt) { float ps = 0.f;
#pragma unroll
                        for (int kt = 0; kt < 4; ++kt)
#pragma unroll
                            for (int r = 0; r < 4; ++r) { const float p = ex2(s[kt][qt][r]); s[kt][qt][r] = p; ps += p; }
                        lsum[qt] += ps; }
                } else {
#pragma unroll
                    for (int qt = 0; qt < 2; ++qt) {
                        float mx = s[0][qt][0];
#pragma unroll
                        for (int kt = 0; kt < 4; ++kt)
#pragma unroll
                            for (int r = 0; r < 4; ++r) mx = fmaxf(mx, s[kt][qt][r]);
                        mx = fmaxf(mx, __shfl_xor(mx, 16)); mx = fmaxf(mx, __shfl_xor(mx, 32));
                        const float mn = fmaxf(mrun[qt], mx), alpha = ex2(mrun[qt] - mn); mrun[qt] = mn;
                        float ps = 0.f;
#pragma unroll
                        for (int kt = 0; kt < 4; ++kt)
#pragma unroll
                            for (int r = 0; r < 4; ++r) { const float p = ex2(s[kt][qt][r] - mn); s[kt][qt][r] = p; ps += p; }
                        lsum[qt] = lsum[qt] * alpha + ps;
#pragma unroll
                        for (int nt = 0; nt < 8; ++nt) O[nt][qt] = O[nt][qt] * alpha;
                    }
                }
#pragma unroll
                for (int s2 = 0; s2 < 2; ++s2) {
                    const bf16x8 pf0 = pack8(s[2 * s2][0], s[2 * s2 + 1][0]), pf1 = pack8(s[2 * s2][1], s[2 * s2 + 1][1]);
                    const LAS unsigned char* va = vb + (32 * s2 + 4 * fq + (fr >> 2)) * A_VSTR + 4 * (fr & 3) * 2;
#pragma unroll
                    for (int nt = 0; nt < 8; ++nt) {
                        const bf16x8 vfr = cat4(tr_read(va + nt * 32), tr_read(va + nt * 32 + 16 * A_VSTR));
                        O[nt][0] = mfma16(vfr, pf0, O[nt][0]); O[nt][1] = mfma16(vfr, pf1, O[nt][1]);
                    }
                }
            }
            if (SH < 2 && t + 1 < nst) A_WRITE((t + 1) & 1);
            if (SH != 4) LDS_BARRIER();
        }
#pragma unroll
        for (int qt = 0; qt < 2; ++qt) {
            float l = lsum[qt]; l += __shfl_xor(l, 16); l += __shfl_xor(l, 32);
            const float inv = 1.0f / l;
            if (SH == 0 || l == (float)magic)
            { bf16_t* op = Q1 + (qrow0 + 16 * qt + fr) * 2048 + h * 128 + 4 * fq;
#pragma unroll
            for (int nt = 0; nt < 8; ++nt) { u32x2 ow; ow.x = pkbf(O[nt][qt][0] * inv, O[nt][qt][1] * inv); ow.y = pkbf(O[nt][qt][2] * inv, O[nt][qt][3] * inv);
                *(u32x2*)(op + 16 * nt) = ow; } }
        }
#undef A_ISSUE
#undef A_KC
#undef A_WRITE
    }
}

#define XB_TMO      128
#define XB_XCNT(j)  (256  + 64 * (j))
#define XB_XSUB(j)  (1280 + 64 * (j))
#define XB_XGEN(j)  (2304 + 64 * (j))
#define XB_TOP      3328
#define XB_TOPGEN   3392
#define XCD_BAR_WORDS 3456
#define XB_SPIN_CAP (1u << 18)

__device__ __forceinline__ unsigned xb_ld(unsigned* p)              { return __hip_atomic_load(p, __ATOMIC_RELAXED, __HIP_MEMORY_SCOPE_AGENT); }
__device__ __forceinline__ unsigned xb_add(unsigned* p, unsigned v) { return __hip_atomic_fetch_add(p, v, __ATOMIC_RELAXED, __HIP_MEMORY_SCOPE_AGENT); }
__device__ __forceinline__ unsigned xb_xcc_id() { return (unsigned)__builtin_amdgcn_s_getreg((3 << 11) | 20) & 0xFu; }
#define XB_SPIN(cond, bar) do { unsigned _sp = 0; while (cond) { __builtin_amdgcn_s_sleep(1); \
    if ((++_sp & 255u) == 0u) { if (xb_ld(&(bar)[XB_TMO])) break; if (_sp > XB_SPIN_CAP) { atomicAdd(&(bar)[XB_TMO], 1u); break; } } } } while (0)

struct XcdBarrier {
    unsigned* bar; unsigned x;
    volatile LAS unsigned* st;
};

__device__ __forceinline__ XcdBarrier xcd_barrier_post(unsigned* bar, volatile LAS unsigned* st) {
    XcdBarrier b; b.bar = bar; b.x = xb_xcc_id(); b.st = st;
    if (threadIdx.x == 0) (void)xb_add(&bar[XB_XCNT(b.x)], 1u);
    return b;
}
__device__ __forceinline__ void xcd_barrier_complete(unsigned* bar, unsigned x, unsigned& nloc, unsigned& nx) {
    const unsigned G = gridDim.x * gridDim.y * gridDim.z;
    unsigned sum, cnt, mine, sp = 0u;
    for (;;) {
        sum = 0u; cnt = 0u; mine = 0u;
#pragma unroll
        for (unsigned j = 0; j < 16; ++j) { const unsigned c = xb_ld(&bar[XB_XCNT(j)]); sum += c; cnt += (c > 0u) ? 1u : 0u; mine = (j == x) ? c : mine; }
        if (sum == G) break;
        __builtin_amdgcn_s_sleep(1);
        if ((++sp & 255u) == 0u) { if (xb_ld(&bar[XB_TMO])) break; if (sp > XB_SPIN_CAP) { atomicAdd(&bar[XB_TMO], 1u); break; } }
    }
    nloc = mine > 0u ? mine : 1u; nx = cnt > 0u ? cnt : 1u;
}

__device__ __forceinline__ void xcd_barrier(const XcdBarrier& b) {
    asm volatile("s_waitcnt vmcnt(0)" ::: "memory");
    __syncthreads();
    if (threadIdx.x == 0) {
        unsigned* bar = b.bar;
        __builtin_amdgcn_s_waitcnt(0);
        unsigned nloc = b.st[0], nx = b.st[1];
        if (nloc == 0u) { xcd_barrier_complete(bar, b.x, nloc, nx); b.st[0] = nloc; b.st[1] = nx; }
        const unsigned old = xb_add(&bar[XB_XSUB(b.x)], 1u);
        const unsigned gen = old / nloc;
        if (old + 1u == (gen + 1u) * nloc) {
            __builtin_amdgcn_fence(__ATOMIC_RELEASE, "agent");
            asm volatile("s_waitcnt vmcnt(0)" ::: "memory");
            const unsigned og = xb_add(&bar[XB_TOP], 1u);
            const unsigned tg = og / nx;
            if (og + 1u == (tg + 1u) * nx) xb_add(&bar[XB_TOPGEN], 1u);
            else XB_SPIN(xb_ld(&bar[XB_TOPGEN]) == tg, bar);
            __builtin_amdgcn_fence(__ATOMIC_ACQUIRE, "agent");
            xb_add(&bar[XB_XGEN(b.x)], 1u);
            asm volatile("s_waitcnt vmcnt(0)" ::: "memory");
        } else {
            XB_SPIN(xb_ld(&bar[XB_XGEN(b.x)]) == gen, bar);
            __builtin_amdgcn_fence(__ATOMIC_ACQUIRE, "agent");
            asm volatile("s_waitcnt vmcnt(0)" ::: "memory");
        }
    }
    __syncthreads();
}


struct Args { const float* x; const float* c; const int* pos; const float* norm_g; const float* ada_w; const float* ada_b; const float* ret_w_in; const float* ret_gn; const float* ret_w_out;
              const float* att_w_in; const float* att_qg; const float* att_kg; const float* att_rel; const float* att_w_out; float* out; unsigned char* ws; int ph_lo, ph_hi; };
constexpr int NPH = 11;

__global__ void __launch_bounds__(512, 2) mega_fwd(Args a) {
    extern __shared__ __attribute__((aligned(16))) unsigned char lds_raw[];
    __builtin_assume(__builtin_amdgcn_workitem_id_y() == 0); __builtin_assume(__builtin_amdgcn_workitem_id_z() == 0);
    LAS unsigned char* lds = (LAS unsigned char*)lds_raw;
    cg::grid_group grid = cg::this_grid();
    const int tid = threadIdx.x, lane = tid & 63, w = __builtin_amdgcn_readfirstlane(tid >> 6);
    const int G = gridDim.x, bid = blockIdx.x;
    const int vcu = (G % 8 == 0) ? (bid % 8) * (G / 8) + bid / 8 : bid;
    const int gw = bid * 8 + w, NGW = G * 8;
    unsigned char* ws = a.ws;
    bf16_t* H = (bf16_t*)(ws + WS_H);
    const float* mod = (const float*)(ws + WS_MOD);
    const int lo = a.ph_lo, hi = a.ph_hi;
    volatile LAS unsigned* bst = (volatile LAS unsigned*)(lds + LDS_BYTES - 16);
    if (tid < 2) bst[tid] = 0u;
    __syncthreads();
    const XcdBarrier xbar = xcd_barrier_post((unsigned*)(ws + WS_BAR), bst);
    if (lo < 0) grid.sync();
#define IN(k) (lo <= (k) && (k) < hi)
#ifndef PROBE_MASK
#define PROBE_MASK 0
#endif
    unsigned long long t_prev = 0, t_acc = 0;
    if (PROBE_MASK) t_prev = __builtin_amdgcn_s_memrealtime();
#define SEAM(k) do { if (IN(k) && IN((k) + 1)) { xcd_barrier(xbar); } if (PROBE_MASK) { const unsigned long long t_ = __builtin_amdgcn_s_memrealtime(); if ((PROBE_MASK >> (k)) & 1) t_acc += t_ - t_prev; t_prev = t_; } } while (0)
    if (IN(0)) p0_phase(lds, a.c, a.ada_w, a.ada_b, a.ret_w_in, a.ret_w_out, a.att_w_in, a.att_w_out, ws, bid, G);
    SEAM(0);
    if (IN(1)) { sw_items(lds, mod + 8 * 3072, a.att_w_in, 8192, (float*)(ws + WS_SW1), bid, G); ln_phase(a.x, H, a.norm_g, mod, gw, NGW, lane); }
    SEAM(1);
    if (IN(2)) {
        pg8::Gemm g{H, (const bf16_t*)(ws + WS_W0IN), NTOK, 4096, 1024}; pg8::StaticOrder S; S.init(NTOK, 4096, G, bid);
        EpiA0 E{(bf16_t*)(ws + WS_Q0), (bf16_t*)(ws + WS_K0), (bf16_t*)(ws + WS_V0), a.pos, (const float*)(ws + WS_INVF)};
        pg8::gemm_phase<EpiA0, pg8::StaticOrder, true, true>(lds, g, S, E);
    }
    SEAM(2);
    if (IN(3)) { ret_phase<0>(lds, (const bf16_t*)(ws + WS_Q0), (const bf16_t*)(ws + WS_K0), (bf16_t*)(ws + WS_V0), (float*)(ws + WS_SSQ), vcu, G, lo - 1);
        if (PROBE_SHADOW >= 10) ret_phase<PROBE_SHADOW - 9>(lds, (const bf16_t*)(ws + WS_Q0), (const bf16_t*)(ws + WS_K0), (bf16_t*)(ws + WS_V0), (float*)(ws + WS_SSQ), vcu, G, lo - 1); }
    SEAM(3);
    if (IN(4)) {
        pg8::Gemm g{H, (const bf16_t*)(ws + WS_W0IN) + (size_t)4096 * 1024, NTOK, 2048, 1024}; pg8::StaticOrder S; S.init(NTOK, 2048, G, bid);
        EpiG<0> E{(bf16_t*)(ws + WS_V0), (const float*)(ws + WS_SSQ), a.ret_gn, nullptr};
        pg8::gemm_phase<EpiG<0>, pg8::StaticOrder, true, true>(lds, g, S, E);
    }
    SEAM(4);
    if (IN(5)) {
        pg8::Gemm g{(const bf16_t*)(ws + WS_V0), (const bf16_t*)(ws + WS_W0OUT), NTOK, 1024, 2048}; pg8::StaticOrder S; S.init(NTOK, 1024, G, bid);
        EpiOutLN E{a.x, a.out, mod + 2048, H, a.norm_g + 1024, mod + 8 * 3072 + 1024, (float*)(ws + WS_SSQ), (LAS float*)(lds + 131072)};
        pg8::gemm_phase<EpiOutLN, pg8::StaticOrder, true, true>(lds, g, S, E);
    }
    SEAM(5);
    if (IN(7)) {
        pg8::Gemm g{H, (const bf16_t*)(ws + WS_W1IN), NTOK, 6144, 1024}; pg8::StaticOrder S; S.init(NTOK, 6144, G, bid);
        EpiA1 E{(bf16_t*)(ws + WS_Q1), (const float*)(ws + WS_SSQ), (const float*)(ws + WS_SW1)};
        pg8::gemm_phase<EpiA1, pg8::StaticOrder, true, true>(lds, g, S, E);
    }
    SEAM(7);
    if (IN(8)) { att_phase<0>(lds, (bf16_t*)(ws + WS_Q1), (const bf16_t*)(ws + WS_K1), (const bf16_t*)(ws + WS_V1), a.att_qg, a.att_kg, a.att_rel, vcu, G, lo - 1);
        if (PROBE_SHADOW >= 1 && PROBE_SHADOW < 10) att_phase<(PROBE_SHADOW < 10 ? PROBE_SHADOW : 1)>(lds, (bf16_t*)(ws + WS_Q1), (const bf16_t*)(ws + WS_K1), (const bf16_t*)(ws + WS_V1), a.att_qg, a.att_kg, a.att_rel, vcu, G, lo - 1); }
    SEAM(8);
    if (IN(9)) {
        pg8::Gemm g{H, (const bf16_t*)(ws + WS_W1IN) + (size_t)6144 * 1024, NTOK, 2048, 1024}; pg8::StaticOrder S; S.init(NTOK, 2048, G, bid);
        EpiG<1> E{(bf16_t*)(ws + WS_Q1), (const float*)(ws + WS_SSQ), nullptr, (const float*)(ws + WS_SW1)};
        pg8::gemm_phase<EpiG<1>, pg8::StaticOrder, true, true>(lds, g, S, E);
    }
    SEAM(9);
    if (IN(10)) {
        pg8::Gemm g{(const bf16_t*)(ws + WS_Q1), (const bf16_t*)(ws + WS_W1OUT), NTOK, 1024, 2048}; pg8::StaticOrder S; S.init(NTOK, 1024, G, bid);
        EpiOut E{a.out, a.out, mod + 8 * 3072 + 2048};
        pg8::gemm_phase<EpiOut, pg8::StaticOrder, true, true>(lds, g, S, E);
    }
    if (PROBE_MASK) { const unsigned long long t_ = __builtin_amdgcn_s_memrealtime(); if ((PROBE_MASK >> 10) & 1) t_acc += t_ - t_prev;
        if (bid == 0 && tid == 0) { while (__builtin_amdgcn_s_memrealtime() - t_ < t_acc) __builtin_amdgcn_s_sleep(8); } }
#undef IN
#undef SEAM
}

extern "C" void kernel_launch(void* const* d_in, const int* in_sizes, int n_in, void* d_out, int out_size, void* d_ws, size_t ws_size, hipStream_t stream) {
    static int grid = 0;
    if (grid == 0) {
        if (n_in != 14 || out_size != NTOK * DM || ws_size < WS_END) { fprintf(stderr, "kernel_launch: unexpected shapes (n_in %d out %d ws %zu need %zu)\n", n_in, out_size, ws_size, (size_t)WS_END); grid = -1; return; }
        int dev = 0, cus = 0, per_cu = 0;
        hipGetDevice(&dev);
        hipDeviceGetAttribute(&cus, hipDeviceAttributeMultiprocessorCount, dev);
        if (hipFuncSetAttribute((const void*)mega_fwd, hipFuncAttributeMaxDynamicSharedMemorySize, LDS_BYTES) != hipSuccess) { fprintf(stderr, "kernel_launch: hipFuncSetAttribute failed\n"); grid = -1; return; }
        if (hipOccupancyMaxActiveBlocksPerMultiprocessor(&per_cu, (const void*)mega_fwd, 512, LDS_BYTES) != hipSuccess || per_cu < 1) { fprintf(stderr, "kernel_launch: occupancy query says %d\n", per_cu); per_cu = 1; }
        (void)hipGetLastError();
        grid = cus * per_cu;
    }
    if (grid < 0) return;
    Args a{};
    a.x = (const float*)d_in[0]; a.c = (const float*)d_in[1]; a.pos = (const int*)d_in[2]; a.norm_g = (const float*)d_in[3]; a.ada_w = (const float*)d_in[4]; a.ada_b = (const float*)d_in[5];
    a.ret_w_in = (const float*)d_in[6]; a.ret_gn = (const float*)d_in[7]; a.ret_w_out = (const float*)d_in[8]; a.att_w_in = (const float*)d_in[9]; a.att_qg = (const float*)d_in[10];
    a.att_kg = (const float*)d_in[11]; a.att_rel = (const float*)d_in[12]; a.att_w_out = (const float*)d_in[13]; a.out = (float*)d_out; a.ws = (unsigned char*)d_ws;
#if MK_N_LAUNCHES == 1
    if (hipMemsetAsync((unsigned char*)d_ws + WS_BAR, 0, 16384, stream) != hipSuccess) { fprintf(stderr, "kernel_launch: hipMemsetAsync failed\n"); return; }
    a.ph_lo = 0; a.ph_hi = NPH;
    void* args[] = {&a};
    hipError_t e = hipLaunchCooperativeKernel((const void*)mega_fwd, dim3(grid), dim3(512), args, LDS_BYTES, stream);
    if (e != hipSuccess) fprintf(stderr, "kernel_launch: cooperative launch failed: %s (grid %d)\n", hipGetErrorString(e), grid);
#else
    for (int p = 0; p < NPH; ++p) { a.ph_lo = p; a.ph_hi = p + 1; hipLaunchKernelGGL(mega_fwd, dim3(grid), dim3(512), LDS_BYTES, stream, a); }
#endif
}
```
